# Optimizing an MI355X kernel written in HIP

```python
import jax
import jax.numpy as jnp
from jax import lax
import numpy as np

D_MODEL = 1024
BATCH = 16
SEQ = 2048
DEPTH = 2

CTX_LEN = 256
GRID_W = 64
N_MOD = 9
D_FF = ((8 * D_MODEL // 3 + 127) // 128) * 128
MIX_WIDTH = D_MODEL
POOL_WIDTH = D_MODEL // 4
POOL_WINDOWS = (2, 4, 8, 16)
POOL_GROUPS = len(POOL_WINDOWS)
POOL_GROUP = POOL_WIDTH // POOL_GROUPS
RET_WIDTH = D_MODEL // 2
RET_HEADS = 4
RET_HEAD_DIM = RET_WIDTH // RET_HEADS
RET_CHUNK = 128
CONV_WIDTH = D_MODEL // 4
CONV_K = 31
IN_WIDTH = POOL_WIDTH + 4 * RET_WIDTH + 2 * CONV_WIDTH
Q_OFF = POOL_WIDTH
K_OFF = Q_OFF + RET_WIDTH
V_OFF = K_OFF + RET_WIDTH
G_OFF = V_OFF + RET_WIDTH
C_OFF = G_OFF + RET_WIDTH
SPLITS = (Q_OFF, K_OFF, V_OFF, G_OFF, C_OFF)
ROPE_BASE = 10000.0
EPS = 1e-6
F32 = jnp.float32

kernel_name = 'hybrid_pool_retention_conv_dit'


def _rmsnorm(x, g):
    x32 = x.astype(F32)
    y = x32 * lax.rsqrt(jnp.mean(x32 * x32, axis=-1, keepdims=True) + EPS)
    return (y * g.astype(F32)).astype(x.dtype)


def _modulate(h, shift, scale):
    return h * (1 + scale) + shift


def _swiglu(h, w1, w3, w2):
    return (jax.nn.silu(h @ w1) * (h @ w3)) @ w2


def _multiscale_pool(p, pool_w, pool_scale):
    B, L, _ = p.shape
    p32 = p.astype(F32)
    cs = jnp.concatenate([jnp.zeros((B, 1, POOL_WIDTH), F32), jnp.cumsum(p32, axis=1)], axis=1)
    t = jnp.arange(L)
    outs = []
    for gi, w in enumerate(POOL_WINDOWS):
        lo = jnp.clip(t - w // 2, 0, L)
        hi = jnp.clip(t + w // 2, 0, L)
        csg = cs[:, :, gi * POOL_GROUP:(gi + 1) * POOL_GROUP]
        cnt = (hi - lo).astype(F32)[None, :, None]
        outs.append((csg[:, hi] - csg[:, lo]) / cnt - p32[:, :, gi * POOL_GROUP:(gi + 1) * POOL_GROUP])
    pooled = jnp.stack(outs, axis=2)
    mixed = jnp.einsum('blgc,gcd->blgd', pooled, pool_w.astype(F32)).reshape(B, L, POOL_WIDTH)
    return (mixed * pool_scale.astype(F32)).astype(p.dtype)


def _conv_module(u, dw, db, ln_g, ln_b):
    a, gt = jnp.split(u, 2, axis=-1)
    z = a * jax.nn.sigmoid(gt)
    z = lax.conv_general_dilated(z, dw[:, None, :].astype(z.dtype), window_strides=(1,),
                                 padding=[(CONV_K // 2, CONV_K // 2)],
                                 dimension_numbers=('NWC', 'WIO', 'NWC'),
                                 feature_group_count=CONV_WIDTH) + db
    z32 = z.astype(F32)
    mu = jnp.mean(z32, axis=-1, keepdims=True)
    var = jnp.mean(jnp.square(z32 - mu), axis=-1, keepdims=True)
    z32 = (z32 - mu) * lax.rsqrt(var + EPS) * ln_g.astype(F32) + ln_b.astype(F32)
    return jax.nn.silu(z32).astype(u.dtype)


def _heads(t):
    return t.reshape(t.shape[0], t.shape[1], RET_HEADS, RET_HEAD_DIM)


def _rotate(u, ang):
    u1, u2 = jnp.split(u, 2, axis=-1)
    cos = jnp.cos(ang)[None, :, None, :]
    sin = jnp.sin(ang)[None, :, None, :]
    return jnp.concatenate([u1 * cos - u2 * sin, u1 * sin + u2 * cos], axis=-1)


def _axial_rope(t, row, col):
    n_freq = RET_HEAD_DIM // 4
    inv = ROPE_BASE ** (-jnp.arange(n_freq, dtype=F32) / n_freq)
    tr, tc = jnp.split(t.astype(F32), 2, axis=-1)
    return jnp.concatenate([_rotate(tr, row[:, None] * inv[None]),
                            _rotate(tc, col[:, None] * inv[None])], axis=-1)


def _retention_dir(q, k, v, log_gamma, s0, strict):
    B, L, H, Dk = q.shape
    Dv = v.shape[-1]
    n = L // RET_CHUNK
    qc = q.astype(F32).reshape(B, n, RET_CHUNK, H, Dk)
    kc = k.astype(F32).reshape(B, n, RET_CHUNK, H, Dk)
    vc = v.astype(F32).reshape(B, n, RET_CHUNK, H, Dv)
    pos = jnp.arange(RET_CHUNK, dtype=F32)
    diff = pos[:, None] - pos[None, :]
    mask = (diff > 0) if strict else (diff >= 0)
    decay = jnp.where(mask[None], jnp.exp(jnp.maximum(diff, 0.0)[None] * log_gamma[:, None, None]), 0.0)
    scores = jnp.einsum('bnihd,bnjhd->bnhij', qc, kc) * decay[None, None]
    intra = jnp.einsum('bnhij,bnjhe->bnihe', scores, vc)
    w_k = jnp.exp((RET_CHUNK - 1 - pos)[:, None] * log_gamma[None, :])
    kv = jnp.einsum('bnjhd,jh,bnjhe->bnhde', kc, w_k, vc)
    chunk_decay = jnp.exp(RET_CHUNK * log_gamma)[None, :, None, None]

    def step(s, kv_n):
        return chunk_decay * s + kv_n, s

    s_final, s_starts = lax.scan(step, s0, jnp.moveaxis(kv, 1, 0))
    s_starts = jnp.moveaxis(s_starts, 0, 1)
    w_q = jnp.exp((pos + 1.0)[:, None] * log_gamma[None, :])
    cross = jnp.einsum('bnihd,ih,bnhde->bnihe', qc, w_q, s_starts)
    return (intra + cross).reshape(B, L, H, Dv), s_final


def _context_states(k, v, log_gamma_f, log_gamma_b):
    Lc = k.shape[1]
    pos = jnp.arange(Lc, dtype=F32)
    w_f = jnp.exp((Lc - 1 - pos)[:, None] * log_gamma_f[None, :])
    w_b = jnp.exp(pos[:, None] * log_gamma_b[None, :])
    k32 = k.astype(F32)
    v32 = v.astype(F32)
    s_f = jnp.einsum('bjhd,jh,bjhe->bhde', k32, w_f, v32)
    s_b = jnp.einsum('bjhd,jh,bjhe->bhde', k32, w_b, v32)
    return s_f, s_b


def _retention_readout(o, g, gn_g):
    B, L, H, Dv = o.shape
    mu = jnp.mean(o, axis=-1, keepdims=True)
    var = jnp.mean(jnp.square(o - mu), axis=-1, keepdims=True)
    y = ((o - mu) * lax.rsqrt(var + EPS)).reshape(B, L, H * Dv) * gn_g.astype(F32)
    return (y * jax.nn.silu(g.astype(F32))).astype(g.dtype)


def _mixer(hx, hy, w_in, w_out, pool_w, pool_scale, dec_f, dec_b, gn_g,
           conv_dw, conv_b, conv_ln_g, conv_ln_b, need_ctx_out):
    B, L, _ = hx.shape
    lg_f = jax.nn.log_sigmoid(dec_f.astype(F32))
    lg_b = jax.nn.log_sigmoid(dec_b.astype(F32))
    k_scale = RET_HEAD_DIM ** -0.5
    rows = L // GRID_W
    row = jnp.repeat(jnp.arange(rows, dtype=F32), GRID_W)
    col = jnp.tile(jnp.arange(GRID_W, dtype=F32), rows)

    if need_ctx_out:
        pool_y, qy, ky, vy, gy, conv_y = jnp.split(hy @ w_in, SPLITS, axis=-1)
        qy = _heads(qy)
        ky = _heads(ky) * k_scale
        vy = _heads(vy)
        s0 = jnp.zeros((hy.shape[0], RET_HEADS, RET_HEAD_DIM, RET_HEAD_DIM), F32)
        oy_f, s_f = _retention_dir(qy, ky, vy, lg_f, s0, False)
        oy_b, s_b = _retention_dir(jnp.flip(qy, 1), jnp.flip(ky, 1), jnp.flip(vy, 1), lg_b, s0, True)
        ret_y = _retention_readout(oy_f + jnp.flip(oy_b, 1), gy, gn_g)
        cat_y = jnp.concatenate([_multiscale_pool(pool_y, pool_w, pool_scale), ret_y,
                                 _conv_module(conv_y, conv_dw, conv_b, conv_ln_g, conv_ln_b)], axis=-1)
        out_y = cat_y @ w_out
    else:
        ky, vy = jnp.split(hy @ w_in[:, K_OFF:G_OFF], 2, axis=-1)
        s_f, s_b = _context_states(_heads(ky) * k_scale, _heads(vy), lg_f, lg_b)
        out_y = None

    pool_x, qx, kx, vx, gx, conv_x = jnp.split(hx @ w_in, SPLITS, axis=-1)
    qx = _axial_rope(_heads(qx), row, col)
    kx = _axial_rope(_heads(kx), row, col) * k_scale
    vx = _heads(vx)
    ox_f, _ = _retention_dir(qx, kx, vx, lg_f, s_f, False)
    ox_b, _ = _retention_dir(jnp.flip(qx, 1), jnp.flip(kx, 1), jnp.flip(vx, 1), lg_b, s_b, True)
    ret_x = _retention_readout(ox_f + jnp.flip(ox_b, 1), gx, gn_g)
    cat_x = jnp.concatenate([_multiscale_pool(pool_x, pool_w, pool_scale), ret_x,
                             _conv_module(conv_x, conv_dw, conv_b, conv_ln_g, conv_ln_b)], axis=-1)
    return cat_x @ w_out, out_y


def setup_inputs(seed: int = 0) -> dict:
    key = jax.random.key(seed)
    ks = jax.random.split(key, 24)

    def nrm(k, shape, scale):
        return jax.random.normal(k, shape, F32) * scale

    decay_base = jnp.log(2.0 ** (5.0 + jnp.arange(RET_HEADS, dtype=F32)) - 1.0)
    return {
        'x': nrm(ks[0], (BATCH, SEQ, D_MODEL), 1.0),
        'c': nrm(ks[1], (BATCH, D_MODEL), 1.0),
        'ctx': nrm(ks[2], (BATCH, CTX_LEN, D_MODEL), 1.0),
        'c_ctx': nrm(ks[3], (D_MODEL,), 1.0),
        'w_mod': nrm(ks[4], (DEPTH, D_MODEL, N_MOD * D_MODEL), 0.02),
        'b_mod': nrm(ks[5], (DEPTH, N_MOD * D_MODEL), 0.02),
        'norm_g': 1.0 + nrm(ks[6], (DEPTH, 3, D_MODEL), 0.02),
        'ffn_w1': nrm(ks[7], (DEPTH, 2, D_MODEL, D_FF), D_MODEL ** -0.5),
        'ffn_w3': nrm(ks[8], (DEPTH, 2, D_MODEL, D_FF), D_MODEL ** -0.5),
        'ffn_w2': nrm(ks[9], (DEPTH, 2, D_FF, D_MODEL), D_FF ** -0.5),
        'w_in': nrm(ks[10], (DEPTH, D_MODEL, IN_WIDTH), D_MODEL ** -0.5),
        'w_out': nrm(ks[11], (DEPTH, MIX_WIDTH, D_MODEL), MIX_WIDTH ** -0.5),
        'pool_w': nrm(ks[12], (DEPTH, POOL_GROUPS, POOL_GROUP, POOL_GROUP), POOL_GROUP ** -0.5),
        'pool_scale': 1.0 + nrm(ks[13], (DEPTH, POOL_WIDTH), 0.02),
        'ret_decay_fwd': decay_base + nrm(ks[14], (DEPTH, RET_HEADS), 0.1),
        'ret_decay_bwd': decay_base + nrm(ks[15], (DEPTH, RET_HEADS), 0.1),
        'ret_gn_g': 1.0 + nrm(ks[16], (DEPTH, RET_WIDTH), 0.02),
        'conv_dw': nrm(ks[17], (DEPTH, CONV_K, CONV_WIDTH), CONV_K ** -0.5),
        'conv_b': nrm(ks[18], (DEPTH, CONV_WIDTH), 0.02),
        'conv_ln_g': 1.0 + nrm(ks[19], (DEPTH, CONV_WIDTH), 0.02),
        'conv_ln_b': nrm(ks[20], (DEPTH, CONV_WIDTH), 0.02),
        'final_g': 1.0 + nrm(ks[21], (D_MODEL,), 0.02),
    }


def reference(x, c, ctx, c_ctx, w_mod, b_mod, norm_g, ffn_w1, ffn_w3, ffn_w2, w_in, w_out,
              pool_w, pool_scale, ret_decay_fwd, ret_decay_bwd, ret_gn_g, conv_dw, conv_b,
              conv_ln_g, conv_ln_b, final_g):
    y = ctx
    for l in range(DEPTH):
        last = l == DEPTH - 1
        mx = jnp.split((jax.nn.silu(c) @ w_mod[l] + b_mod[l])[:, None, :], N_MOD, axis=-1)
        my = jnp.split((jax.nn.silu(c_ctx) @ w_mod[l] + b_mod[l])[None, None, :], N_MOD, axis=-1)

        x = x + 0.5 * mx[2] * _swiglu(_modulate(_rmsnorm(x, norm_g[l, 0]), mx[0], mx[1]),
                                      ffn_w1[l, 0], ffn_w3[l, 0], ffn_w2[l, 0])
        y = y + 0.5 * my[2] * _swiglu(_modulate(_rmsnorm(y, norm_g[l, 0]), my[0], my[1]),
                                      ffn_w1[l, 0], ffn_w3[l, 0], ffn_w2[l, 0])

        hx = _modulate(_rmsnorm(x, norm_g[l, 1]), mx[3], mx[4])
        hy = _modulate(_rmsnorm(y, norm_g[l, 1]), my[3], my[4])
        ox, oy = _mixer(hx, hy, w_in[l], w_out[l], pool_w[l], pool_scale[l], ret_decay_fwd[l],
                        ret_decay_bwd[l], ret_gn_g[l], conv_dw[l], conv_b[l], conv_ln_g[l],
                        conv_ln_b[l], not last)
        x = x + mx[5] * ox
        if not last:
            y = y + my[5] * oy

        x = x + 0.5 * mx[8] * _swiglu(_modulate(_rmsnorm(x, norm_g[l, 2]), mx[6], mx[7]),
                                      ffn_w1[l, 1], ffn_w3[l, 1], ffn_w2[l, 1])
        if not last:
            y = y + 0.5 * my[8] * _swiglu(_modulate(_rmsnorm(y, norm_g[l, 2]), my[6], my[7]),
                                          ffn_w1[l, 1], ffn_w3[l, 1], ffn_w2[l, 1])
    return _rmsnorm(x, final_g)
```

```cpp
#include <hip/hip_runtime.h>
#include <hip/hip_cooperative_groups.h>
#include <cstdio>
#include <cstdint>
namespace cg = cooperative_groups;

#ifndef ONE_LAUNCH
#define ONE_LAUNCH 0
#endif

#ifndef SMASK
#define SMASK 0xfff
#endif
#ifndef PHMASK
#define PHMASK 0xffff
#endif
#define LAS __attribute__((address_space(3)))
typedef unsigned short bf16_t;
typedef short bf16x8 __attribute__((ext_vector_type(8)));
typedef float f32x4 __attribute__((ext_vector_type(4)));
typedef unsigned u32x4 __attribute__((ext_vector_type(4)));
typedef unsigned u32x2 __attribute__((ext_vector_type(2)));

constexpr int D = 1024, NB = 16, SEQ = 2048, CTXL = 256, DFF = 2816, INW = 2816;
constexpr int ML = NB * SEQ, MC = NB * CTXL, MT = ML + MC;
constexpr int PBW = 2560;
constexpr float EPS = 1e-6f;
constexpr int NPH = 26;
constexpr int LDS_BYTES = 147456;

constexpr size_t WS_MX = 4096;
constexpr size_t WS_ROPE = WS_MX + 1253376;
constexpr size_t WS_PWT = WS_ROPE + 16384;
constexpr size_t WS_WT = 2097152;
constexpr size_t WT_LAYER = 21233664;
constexpr size_t WT_G1A = 0, WT_G2A = 5767168, WT_WIN = 8650752, WT_WOUT = 11534336, WT_G1B = 12582912, WT_G2B = 18350080;
constexpr size_t WS_XC = WS_WT + 2 * WT_LAYER * 2;
constexpr size_t WS_H = WS_XC + (size_t)MC * D * 4;
constexpr size_t WS_HID = WS_H + (size_t)MT * D * 2;
constexpr size_t WS_KV = WS_HID + (size_t)MT * DFF * 2;
constexpr size_t WS_END = WS_KV + (size_t)2 * 1152 * 16384 * 2;

struct Args { const float* in[22]; float* out; unsigned char* ws; int ph_lo, ph_hi; };

typedef float f32x2_t __attribute__((ext_vector_type(2)));
typedef __bf16 bf16x2_t __attribute__((ext_vector_type(2)));
__device__ __forceinline__ unsigned cvt_pk(float lo, float hi) { const f32x2_t v = {lo, hi}; const bf16x2_t b = __builtin_convertvector(v, bf16x2_t); return __builtin_bit_cast(unsigned, b); }
__device__ __forceinline__ float bf_lo(unsigned w) { return __uint_as_float(w << 16); }
__device__ __forceinline__ float bf_hi(unsigned w) { return __uint_as_float(w & 0xffff0000u); }
__device__ __forceinline__ float sigmoid_f(float x) { return __builtin_amdgcn_rcpf(1.f + __expf(-x)); }
__device__ __forceinline__ float silu_f(float x) { return x * sigmoid_f(x); }
__device__ __forceinline__ float wave_sum(float v) {
#pragma unroll
    for (int o = 1; o < 64; o <<= 1) v += __shfl_xor(v, o);
    return v;
}
__device__ __forceinline__ float log2gamma(const float* dec, int l, int h) { const float x = dec[l * 4 + h]; return -log1pf(expf(-x)) * 1.4426950408889634f; }

constexpr int BM = 256, BK = 64, HALF = 128, HTB = HALF * BK * 2, NXCD = 8, WGM = 8;
__device__ __forceinline__ int lds_byte(int r, int c) { const int st = (r >> 4) * 2 + (c >> 5), rr = r & 15, cc = c & 31, ob = rr * 64 + cc * 2; return st * 1024 + (ob ^ (((ob >> 9) & 1) << 5)); }
__device__ __forceinline__ void stage_rc(int b, int& R, int& C) { const int st = b / 1024, sb = b % 1024, swz = sb ^ (((sb >> 9) & 1) << 5); R = (st >> 1) * 16 + swz / 64; C = (st & 1) * 32 + (swz % 64) / 2; }
struct Unit { int pm, pn; };
struct Gemm { const bf16_t* A; const bf16_t* Bt; int K; };
struct Order {
    int nM, nN, nwg, G, c, xn, xm0, xmn, xn0;
    __device__ void init(int nM_, int nN_, int G_, int c_) { nM = nM_; nN = nN_; nwg = nM * nN; G = G_; c = c_; xn = 0; xm0 = 0; xmn = 1; xn0 = 0; }
    __device__ bool next(int i, Unit& u) const {
        const long L = (long)i * G + c;
        if (L >= nwg) { const int e = (int)(L - nwg); if (e >= xn) return false; u.pm = xm0 + e % xmn; u.pn = xn0 + e / xmn; return true; }
        int wgid = (int)L; { const int q = nwg / NXCD, r = nwg % NXCD, xcd = wgid % NXCD, off = wgid / NXCD; wgid = (xcd < r ? xcd * (q + 1) : r * (q + 1) + (xcd - r) * q) + off; }
        const int nig = WGM * nN, gid = wgid / nig, fm = gid * WGM, gsz = (nM - fm) < WGM ? (nM - fm) : WGM;
        u.pm = fm + ((wgid % nig) % gsz); u.pn = (wgid % nig) / gsz; return true;
    }
};

struct EpiSwiglu {
    bf16_t* O;
    __device__ __forceinline__ void operator()(const f32x4 (&acc)[2][2][4][2], const Unit& u, int wr, int wc, int fr, int fq) const {
        const int row0 = u.pm * BM + wr * 64 + fr, col0 = u.pn * 128 + wc * 32 + 8 * fq;
#pragma unroll
        for (int ai = 0; ai < 2; ++ai)
#pragma unroll
            for (int m = 0; m < 4; ++m) {
                bf16_t* p = O + (size_t)(row0 + ai * HALF + m * 16) * DFF + col0;
                const f32x4 a0 = acc[ai][0][m][0], a1 = acc[ai][0][m][1], b0 = acc[ai][1][m][0], b1 = acc[ai][1][m][1];
                u32x4 w;
                w.x = cvt_pk(silu_f(a0[0]) * b0[0], silu_f(a0[1]) * b0[1]); w.y = cvt_pk(silu_f(a0[2]) * b0[2], silu_f(a0[3]) * b0[3]);
                w.z = cvt_pk(silu_f(a1[0]) * b1[0], silu_f(a1[1]) * b1[1]); w.w = cvt_pk(silu_f(a1[2]) * b1[2], silu_f(a1[3]) * b1[3]);
                *(u32x4*)p = w;
            }
    }
};
struct EpiResid {
    const float* res_lat; const float* res_ctx; float* out_lat; float* out_ctx; const float* mx; int gate_off; float coef;
    __device__ __forceinline__ void operator()(const f32x4 (&acc)[2][2][4][2], const Unit& u, int wr, int wc, int fr, int fq) const {
        const bool lat = u.pm < 128; const int b = lat ? (u.pm >> 3) : 16;
        const float* res = lat ? res_lat + (size_t)u.pm * BM * D : res_ctx + (size_t)(u.pm - 128) * BM * D;
        float* out = lat ? out_lat + (size_t)u.pm * BM * D : out_ctx + (size_t)(u.pm - 128) * BM * D;
        const int col0 = u.pn * BM + wc * 32 + 4 * fq;
        const float* gp = mx + b * 9216 + gate_off + col0;
        f32x4 g[2][2];
#pragma unroll
        for (int bj = 0; bj < 2; ++bj)
#pragma unroll
            for (int n = 0; n < 2; ++n) g[bj][n] = *(const f32x4*)(gp + bj * HALF + n * 16) * coef;
#pragma unroll
        for (int ai = 0; ai < 2; ++ai)
#pragma unroll
            for (int m = 0; m < 4; ++m) {
                const size_t off = (size_t)(ai * HALF + wr * 64 + m * 16 + fr) * D + col0;
#pragma unroll
                for (int bj = 0; bj < 2; ++bj)
#pragma unroll
                    for (int n = 0; n < 2; ++n) {
                        const f32x4 r = *(const f32x4*)(res + off + bj * HALF + n * 16);
                        *(f32x4*)(out + off + bj * HALF + n * 16) = r + g[bj][n] * acc[ai][bj][m][n];
                    }
                asm volatile("" ::: "memory");
            }
    }
};
struct EpiWin {
    bf16_t* PB; const float* rc; const float* rs;
    __device__ __forceinline__ void operator()(const f32x4 (&acc)[2][2][4][2], const Unit& u, int wr, int wc, int fr, int fq) const {
        const int pn = u.pn, rowb = u.pm * BM + wr * 64 + fr;
        if (pn >= 1 && pn <= 4) {
            const bool lat = u.pm < 128; const float ksc = (pn >= 3) ? 0.08838834764831845f : 1.f;
            const int s = wc >> 1, f0 = 16 * (wc & 1) + 4 * fq;
#pragma unroll
            for (int ai = 0; ai < 2; ++ai)
#pragma unroll
                for (int m = 0; m < 4; ++m) {
                    const int r = rowb + ai * HALF + m * 16;
                    f32x4 cs = (f32x4){ksc, ksc, ksc, ksc}, sn = (f32x4){0.f, 0.f, 0.f, 0.f};
                    if (lat) { const int t = r & 2047, pos = s ? (t & 63) : (t >> 6); cs = *(const f32x4*)(rc + pos * 32 + f0) * ksc; sn = *(const f32x4*)(rs + pos * 32 + f0) * ksc; }
#pragma unroll
                    for (int bj = 0; bj < 2; ++bj) {
                        const f32x4 u1 = acc[ai][bj][m][0], u2 = acc[ai][bj][m][1];
                        const f32x4 o1 = u1 * cs - u2 * sn, o2 = u1 * sn + u2 * cs;
                        bf16_t* p = PB + (size_t)r * PBW + 256 * pn + 128 * bj + 64 * s + f0;
                        u32x2 w1, w2; w1.x = cvt_pk(o1[0], o1[1]); w1.y = cvt_pk(o1[2], o1[3]); w2.x = cvt_pk(o2[0], o2[1]); w2.y = cvt_pk(o2[2], o2[3]);
                        *(u32x2*)p = w1; *(u32x2*)(p + 32) = w2;
                    }
                }
        } else if (pn >= 9) {
            const int col0 = 2304 + 128 * (pn - 9) + wc * 32 + 8 * fq;
#pragma unroll
            for (int ai = 0; ai < 2; ++ai)
#pragma unroll
                for (int m = 0; m < 4; ++m) {
                    const int r = rowb + ai * HALF + m * 16;
                    const f32x4 a0 = acc[ai][0][m][0], a1 = acc[ai][0][m][1], g0 = acc[ai][1][m][0], g1 = acc[ai][1][m][1];
                    u32x4 w;
                    w.x = cvt_pk(a0[0] * sigmoid_f(g0[0]), a0[1] * sigmoid_f(g0[1])); w.y = cvt_pk(a0[2] * sigmoid_f(g0[2]), a0[3] * sigmoid_f(g0[3]));
                    w.z = cvt_pk(a1[0] * sigmoid_f(g1[0]), a1[1] * sigmoid_f(g1[1])); w.w = cvt_pk(a1[2] * sigmoid_f(g1[2]), a1[3] * sigmoid_f(g1[3]));
                    *(u32x4*)(PB + (size_t)r * PBW + col0) = w;
                }
        } else {
            const int col0 = 256 * pn + wc * 32 + 8 * fq;
#pragma unroll
            for (int ai = 0; ai < 2; ++ai)
#pragma unroll
                for (int m = 0; m < 4; ++m) {
                    const int r = rowb + ai * HALF + m * 16;
#pragma unroll
                    for (int bj = 0; bj < 2; ++bj) {
                        const f32x4 v0 = acc[ai][bj][m][0], v1 = acc[ai][bj][m][1];
                        u32x4 w; w.x = cvt_pk(v0[0], v0[1]); w.y = cvt_pk(v0[2], v0[3]); w.z = cvt_pk(v1[0], v1[1]); w.w = cvt_pk(v1[2], v1[3]);
                        *(u32x4*)(PB + (size_t)r * PBW + col0 + 128 * bj) = w;
                    }
                }
        }
    }
};

template <class Epi, bool ALIGN_EPI>
__device__ __forceinline__ void gemm_phase(LAS unsigned char* lds, const Gemm g, const Order& S, const Epi& E) {
    int tid_ = threadIdx.x; asm volatile("" : "+v"(tid_));
    const int tid = tid_, wid = __builtin_amdgcn_readfirstlane(tid >> 6), lane = tid & 63, wr = wid >> 2, wc = wid & 3, fr = lane & 15, fq = lane >> 4;
    const int K = g.K, nt = K / BK;
    unsigned voff[2];
#pragma unroll
    for (int i = 0; i < 2; ++i) { int R, C; stage_rc(tid * 16 + i * 8192, R, C); voff[i] = (unsigned)(R * K + C) * 2u; }
    const size_t kstep = (size_t)(BK * 2);
    const size_t hstep = (size_t)HALF * K * 2;
    const size_t tstep = 2 * hstep;
    const unsigned ldsw = (unsigned)wid * 1024u;
    const int aoff = lds_byte(wr * 64 + fr, fq * 8), boff = lds_byte(wc * 32 + fr, fq * 8);
#define PG8_SA(b, h) (((b) * 2 + (h)) * HTB)
#define PG8_SB(b, h) ((4 + (b) * 2 + (h)) * HTB)
#define PG8_STAGE(bufoff, gbase) do { _Pragma("unroll") for (int _i = 0; _i < 2; ++_i) \
        __builtin_amdgcn_global_load_lds((const unsigned*)((const char*)(gbase) + voff[_i]), (LAS unsigned*)(lds + (bufoff) + ldsw + _i * 8192), 16, 0, 0); } while (0)
#define PG8_LDA(dst, b, h) do { _Pragma("unroll") for (int m = 0; m < 4; ++m) _Pragma("unroll") for (int k = 0; k < 2; ++k) dst[m][k] = *(const LAS bf16x8*)(lds + PG8_SA(b, h) + aoff + m * 2048 + k * 1024); } while (0)
#define PG8_LDB(dst, b, h) do { _Pragma("unroll") for (int n = 0; n < 2; ++n) _Pragma("unroll") for (int k = 0; k < 2; ++k) dst[n][k] = *(const LAS bf16x8*)(lds + PG8_SB(b, h) + boff + n * 2048 + k * 1024); } while (0)
#define PG8_MMA(ai, bj, At, Bt) do { __builtin_amdgcn_s_setprio(1); _Pragma("unroll") for (int m = 0; m < 4; ++m) _Pragma("unroll") for (int n = 0; n < 2; ++n) _Pragma("unroll") for (int k = 0; k < 2; ++k) \
        acc[ai][bj][m][n] = __builtin_amdgcn_mfma_f32_16x16x32_bf16(Bt[n][k], At[m][k], acc[ai][bj][m][n], 0, 0, 0); __builtin_amdgcn_s_setprio(0); } while (0)
#define PG8_WAIT_V(n) asm volatile("s_waitcnt vmcnt(" #n ")" ::: "memory")
#define PG8_WAIT_L(n) asm volatile("s_waitcnt lgkmcnt(" #n ")" ::: "memory")
#define PG8_BAR __builtin_amdgcn_s_barrier()
#define PG8_SCHED __builtin_amdgcn_sched_barrier(0)
    Unit cur, nxt; int ui = 0;
    if (!S.next(0, cur)) return;
    f32x4 acc[2][2][4][2];
#pragma unroll
    for (int a = 0; a < 2; ++a)
#pragma unroll
        for (int b = 0; b < 2; ++b)
#pragma unroll
            for (int m = 0; m < 4; ++m)
#pragma unroll
                for (int n = 0; n < 2; ++n) acc[a][b][m][n] = (f32x4){0.f, 0.f, 0.f, 0.f};
    bf16x8 At[4][2], B0[2][2], B1[2][2];
    const char* cA = (const char*)g.A + (size_t)cur.pm * tstep; const char* cB = (const char*)g.Bt + (size_t)cur.pn * tstep;
    PG8_STAGE(PG8_SB(0, 0), cB); PG8_STAGE(PG8_SB(0, 1), cB + hstep); PG8_STAGE(PG8_SA(0, 0), cA); PG8_STAGE(PG8_SA(0, 1), cA + hstep);
    if (wr == 1) PG8_BAR;
    PG8_WAIT_V(2); PG8_BAR;
    PG8_STAGE(PG8_SB(1, 0), cB + kstep); PG8_STAGE(PG8_SA(1, 0), cA + kstep); PG8_STAGE(PG8_SB(1, 1), cB + hstep + kstep);
    PG8_WAIT_V(6); PG8_BAR;
    for (;;) {
        const bool has_next = S.next(ui + 1, nxt);
        const char* nA = has_next ? (const char*)g.A + (size_t)nxt.pm * tstep : cA; const char* nB = has_next ? (const char*)g.Bt + (size_t)nxt.pn * tstep : cB;
        for (int t = 0; t < nt; t += 2) {
            const bool last = (t == nt - 2);
            const char* a1 = cA + (size_t)(t + 1) * kstep;
            const char* a2 = last ? nA : cA + (size_t)(t + 2) * kstep; const char* b2 = last ? nB : cB + (size_t)(t + 2) * kstep;
            const char* a3 = a2 + kstep; const char* b3 = b2 + kstep;
            PG8_LDB(B0, 0, 0); PG8_LDB(B1, 0, 1); PG8_SCHED; PG8_LDA(At, 0, 0); PG8_STAGE(PG8_SA(1, 1), a1 + hstep);
            PG8_WAIT_V(8); PG8_WAIT_L(0); PG8_BAR; PG8_MMA(0, 0, At, B0); PG8_MMA(0, 1, At, B1); PG8_BAR; PG8_SCHED;
            PG8_LDA(At, 0, 1); PG8_STAGE(PG8_SB(0, 0), b2); PG8_STAGE(PG8_SB(0, 1), b2 + hstep); PG8_STAGE(PG8_SA(0, 0), a2);
            PG8_WAIT_V(8); PG8_WAIT_L(0); PG8_BAR; PG8_MMA(1, 0, At, B0); PG8_MMA(1, 1, At, B1); PG8_BAR; PG8_SCHED;
            PG8_LDB(B0, 1, 0); PG8_LDB(B1, 1, 1); PG8_SCHED; PG8_LDA(At, 1, 0); PG8_STAGE(PG8_SA(0, 1), a2 + hstep);
            PG8_WAIT_V(8); PG8_WAIT_L(0); PG8_BAR; PG8_MMA(0, 0, At, B0); PG8_MMA(0, 1, At, B1); PG8_BAR; PG8_SCHED;
            PG8_LDA(At, 1, 1); PG8_STAGE(PG8_SB(1, 0), b3); PG8_STAGE(PG8_SB(1, 1), b3 + hstep); PG8_STAGE(PG8_SA(1, 0), a3);
            PG8_WAIT_V(8); PG8_WAIT_L(0); PG8_BAR; PG8_MMA(1, 0, At, B0); PG8_MMA(1, 1, At, B1); PG8_BAR; PG8_SCHED;
        }
        if constexpr (ALIGN_EPI) { if (wr == 0) PG8_BAR; }
        E(acc, cur, wr, wc, fr, fq);
        if (!has_next) break;
#pragma unroll
        for (int a = 0; a < 2; ++a)
#pragma unroll
            for (int b = 0; b < 2; ++b)
#pragma unroll
                for (int m = 0; m < 4; ++m)
#pragma unroll
                    for (int n = 0; n < 2; ++n) acc[a][b][m][n] = (f32x4){0.f, 0.f, 0.f, 0.f};
        cur = nxt; cA = nA; cB = nB; ++ui;
        if constexpr (ALIGN_EPI) { if (wr == 1) PG8_BAR; }
    }
    PG8_WAIT_V(0);
    if constexpr (!ALIGN_EPI) { if (wr == 0) PG8_BAR; }
    PG8_BAR;
#undef PG8_SA
#undef PG8_SB
#undef PG8_STAGE
#undef PG8_LDA
#undef PG8_LDB
#undef PG8_MMA
#undef PG8_WAIT_V
#undef PG8_WAIT_L
#undef PG8_BAR
#undef PG8_SCHED
}

__device__ __forceinline__ const float* wsrc(const Args& a, int l, int mat, int rho, int& ldw) {
    const int j = rho & 3, fq = (rho >> 2) & 3, n = (rho >> 4) & 1, wc = (rho >> 5) & 3, bj = (rho >> 7) & 1, pn = rho >> 8;
    const int p8 = 8 * fq + 4 * n + j;
    if (mat == 0 || mat == 4) { const int s = (mat == 4); ldw = DFF; return (bj ? a.in[8] : a.in[7]) + (size_t)(l * 2 + s) * D * DFF + (128 * pn + 32 * wc + p8); }
    if (mat == 1 || mat == 5) { const int s = (mat == 5); ldw = D; return a.in[9] + (size_t)(l * 2 + s) * DFF * D + rho; }
    if (mat == 3) { ldw = D; return a.in[11] + (size_t)l * D * D + rho; }
    ldw = INW; int c;
    if (pn >= 1 && pn <= 4) { const int hh = 2 * ((pn - 1) & 1) + bj; c = (pn < 3 ? 256 : 768) + hh * 128 + 64 * (wc >> 1) + 32 * n + 16 * (wc & 1) + 4 * fq + j; }
    else if (pn >= 9) c = 2304 + 256 * bj + 128 * (pn - 9) + 32 * wc + p8;
    else c = (rho & ~31) + p8;
    return a.in[10] + (size_t)l * D * INW + c;
}

__device__ __forceinline__ void prep_phase(const Args& a, LAS unsigned char* lds, int tid, int bid, int G) {
    constexpr int N_MOD = 288, N_TR = 5184;
    float* MX = (float*)(a.ws + WS_MX);
    for (int it = bid; it < N_MOD + N_TR + 2; it += G) {
        if (it < N_MOD) {
            const int l = it / 144, n0 = (it % 144) * 64;
            LAS float* Sv = (LAS float*)lds;
            LAS float* RED = (LAS float*)(lds + 69632);
            for (int idx = tid; idx < 17 * 1024; idx += 512) { const int r = idx >> 10, k = idx & 1023; const float v = r < 16 ? a.in[1][r * 1024 + k] : a.in[3][k]; Sv[idx] = v / (1.f + expf(-v)); }
            __syncthreads();
            const int ks = tid >> 6, col = tid & 63;
            float acc[17];
#pragma unroll
            for (int r = 0; r < 17; ++r) acc[r] = 0.f;
            const float* wp = a.in[4] + ((size_t)l * 1024 + ks * 128) * 9216 + n0 + col;
#pragma unroll 4
            for (int kk = 0; kk < 128; ++kk) {
                const float w = wp[(size_t)kk * 9216];
#pragma unroll
                for (int r = 0; r < 17; ++r) acc[r] += Sv[r * 1024 + ks * 128 + kk] * w;
            }
#pragma unroll
            for (int r = 0; r < 17; ++r) RED[(ks * 17 + r) * 64 + col] = acc[r];
            __syncthreads();
            for (int idx = tid; idx < 17 * 64; idx += 512) {
                const int r = idx >> 6, c2 = idx & 63; float s = a.in[5][l * 9216 + n0 + c2];
#pragma unroll
                for (int k8 = 0; k8 < 8; ++k8) s += RED[(k8 * 17 + r) * 64 + c2];
                MX[(size_t)(l * 17 + r) * 9216 + n0 + c2] = s;
            }
            __syncthreads();
        } else if (it < N_MOD + N_TR) {
            const int t = it - N_MOD; const int l = t / 2592; int r = t % 2592; int mat; size_t moff;
            if (r < 704) { mat = 0; moff = WT_G1A; } else if (r < 1056) { mat = 1; r -= 704; moff = WT_G2A; } else if (r < 1408) { mat = 2; r -= 1056; moff = WT_WIN; }
            else if (r < 1536) { mat = 3; r -= 1408; moff = WT_WOUT; } else if (r < 2240) { mat = 4; r -= 1536; moff = WT_G1B; } else { mat = 5; r -= 2240; moff = WT_G2B; }
            const int K = (mat == 1 || mat == 5) ? DFF : D, nkt = K / 256, rt = r / nkt, kt = r % nkt, rho0 = rt * 32, k0 = kt * 256;
            int ldw; const float* src = wsrc(a, l, mat, rho0 + (tid & 31), ldw);
            LAS bf16_t* T = (LAS bf16_t*)lds;
            float v[16];
#pragma unroll
            for (int i = 0; i < 16; ++i) v[i] = src[(size_t)(k0 + (tid >> 5) + 16 * i) * ldw];
#pragma unroll
            for (int i = 0; i < 16; ++i) T[(tid & 31) * 258 + (tid >> 5) + 16 * i] = (bf16_t)(cvt_pk(v[i], 0.f) & 0xffffu);
            __syncthreads();
            const int r2 = tid >> 4, seg = tid & 15;
            const LAS unsigned* tp = (const LAS unsigned*)(lds + r2 * 516 + seg * 32);
            u32x4 o0, o1; o0.x = tp[0]; o0.y = tp[1]; o0.z = tp[2]; o0.w = tp[3]; o1.x = tp[4]; o1.y = tp[5]; o1.z = tp[6]; o1.w = tp[7];
            bf16_t* dst = (bf16_t*)(a.ws + WS_WT) + (size_t)l * WT_LAYER + moff + (size_t)(rho0 + r2) * K + k0 + seg * 16;
            *(u32x4*)dst = o0; *(u32x4*)(dst + 8) = o1;
            __syncthreads();
        } else if (it == N_MOD + N_TR) {
            float* rc = (float*)(a.ws + WS_ROPE); float* rs = rc + 2048;
            for (int idx = tid; idx < 2048; idx += 512) { const int pos = idx >> 5, f = idx & 31; const float inv = powf(10000.f, -(float)f / 32.f); float sv, cv; sincosf((float)pos * inv, &sv, &cv); rc[idx] = cv; rs[idx] = sv; }
        } else {
            bf16_t* pwt = (bf16_t*)(a.ws + WS_PWT);
            for (int idx = tid; idx < 2 * 4 * 64 * 64; idx += 512) { const int c = idx & 63, d = (idx >> 6) & 63, lg = idx >> 12; pwt[idx] = (bf16_t)(cvt_pk(a.in[12][(lg * 64 + c) * 64 + d], 0.f) & 0xffffu); }
        }
    }
}

__device__ __forceinline__ void norm_phase(const Args& a, int l, int s, int nrows, const float* xl, const float* xc, int lane, int wid, int bid, int G) {
    const float* MX = (const float*)(a.ws + WS_MX); bf16_t* H = (bf16_t*)(a.ws + WS_H);
    const float* gp = a.in[6] + (l * 3 + s) * D;
    for (int row = bid * 8 + wid; row < nrows; row += G * 8) {
        const bool lat = row < ML; const int b = lat ? (row >> 11) : 16;
        const f32x4* xr = (const f32x4*)(lat ? xl + (size_t)row * D : xc + (size_t)(row - ML) * D) + lane;
        const float* mp = MX + (size_t)(l * 17 + b) * 9216 + (3 * s) * D;
        f32x4 v[4]; float ss = 0.f;
#pragma unroll
        for (int j = 0; j < 4; ++j) { v[j] = xr[64 * j]; ss += (v[j].x * v[j].x + v[j].y * v[j].y) + (v[j].z * v[j].z + v[j].w * v[j].w); }
        const float rstd = 1.f / sqrtf(wave_sum(ss) * (1.f / D) + EPS);
        u32x2* o8 = (u32x2*)(H + (size_t)row * D) + lane;
#pragma unroll
        for (int j = 0; j < 4; ++j) {
            const int col = 256 * j + 4 * lane;
            const f32x4 g = *(const f32x4*)(gp + col), sh = *(const f32x4*)(mp + col), sc = *(const f32x4*)(mp + D + col);
            const f32x4 h = (v[j] * rstd * g) * (sc + 1.f) + sh;
            u32x2 w; w.x = cvt_pk(h.x, h.y); w.y = cvt_pk(h.z, h.w); o8[64 * j] = w;
        }
    }
}
__device__ __forceinline__ void final_phase(const Args& a, int lane, int wid, int bid, int G) {
    const float* gp = a.in[21];
    for (int row = bid * 8 + wid; row < ML; row += G * 8) {
        f32x4* xr = (f32x4*)(a.out + (size_t)row * D) + lane;
        f32x4 v[4]; float ss = 0.f;
#pragma unroll
        for (int j = 0; j < 4; ++j) { v[j] = xr[64 * j]; ss += (v[j].x * v[j].x + v[j].y * v[j].y) + (v[j].z * v[j].z + v[j].w * v[j].w); }
        const float rstd = 1.f / sqrtf(wave_sum(ss) * (1.f / D) + EPS);
#pragma unroll
        for (int j = 0; j < 4; ++j) { const f32x4 g = *(const f32x4*)(gp + 256 * j + 4 * lane); xr[64 * j] = v[j] * rstd * g; }
    }
}

constexpr int TS = 272;
__device__ __forceinline__ void stage_rm(LAS unsigned char* dst, const bf16_t* src, int ld, int tid) {
#pragma unroll
    for (int i = 0; i < 4; ++i) { const int p = tid + 512 * i, row = p >> 4, seg = p & 15; const u32x4 v = *(const u32x4*)(src + (size_t)row * ld + seg * 8); *(LAS u32x4*)(dst + row * TS + seg * 16) = v; }
}
__device__ __forceinline__ void stage_tr(LAS unsigned char* dst, const bf16_t* src, int ld, int tid, bool weighted, float A, float Bc) {
#pragma unroll
    for (int i = 0; i < 2; ++i) {
        const int p = tid + 512 * i, jp = p & 63, o = p >> 6;
        const u32x4 x0 = *(const u32x4*)(src + (size_t)(2 * jp) * ld + o * 8), x1 = *(const u32x4*)(src + (size_t)(2 * jp + 1) * ld + o * 8);
        const float w0 = weighted ? exp2f(A + Bc * (float)(2 * jp)) : 1.f, w1 = weighted ? exp2f(A + Bc * (float)(2 * jp + 1)) : 1.f;
#pragma unroll
        for (int c = 0; c < 8; ++c) {
            const unsigned a0 = x0[c >> 1], a1 = x1[c >> 1];
            const float e0 = (c & 1) ? bf_hi(a0) : bf_lo(a0), e1 = (c & 1) ? bf_hi(a1) : bf_lo(a1);
            *(LAS unsigned*)(dst + (8 * o + c) * TS + 4 * jp) = cvt_pk(e0 * w0, e1 * w1);
        }
    }
}
__device__ __forceinline__ bf16x8 frag(const LAS unsigned char* buf, int row, int ks, int fq) { return *(const LAS bf16x8*)(buf + row * TS + (32 * ks + 8 * fq) * 2); }

__device__ __forceinline__ void chunk_rows(int b, int vf, int& rows0, int& vb) {
    if (vf < 2) { rows0 = ML + b * CTXL + vf * 128; vb = 16 + vf; } else { rows0 = b * SEQ + (vf - 2) * 128; vb = vf - 2; }
}

__device__ __forceinline__ void kv_item(const Args& a, int l, int it, LAS unsigned char* lds, int tid, int lane, int wid) {
    const int b = it / 72, h = (it / 18) & 3, vf = it % 18; int rows0, vb; chunk_rows(b, vf, rows0, vb);
    const bf16_t* PB = (const bf16_t*)(a.ws + WS_HID);
    const bf16_t* Ks = PB + (size_t)rows0 * PBW + 768 + h * 128; const bf16_t* Vs = PB + (size_t)rows0 * PBW + 1280 + h * 128;
    const float lf = log2gamma(a.in[14], l, h), lb = log2gamma(a.in[15], l, h);
    LAS unsigned char* B0 = lds; LAS unsigned char* B1 = lds + 34816; LAS unsigned char* B2 = lds + 69632;
    stage_tr(B0, Ks, PBW, tid, false, 0.f, 0.f);
    stage_tr(B1, Vs, PBW, tid, true, 127.f * lf, -lf);
    stage_tr(B2, Vs, PBW, tid, true, 0.f, lb);
    __syncthreads();
    const int fr = lane & 15, fq = lane >> 4;
    bf16x8 af[4];
#pragma unroll
    for (int ks = 0; ks < 4; ++ks) af[ks] = frag(B0, 16 * wid + fr, ks, fq);
    bf16_t* KVF = (bf16_t*)(a.ws + WS_KV) + ((size_t)(b * 4 + h) * 18 + vf) * 16384;
    bf16_t* KVB = (bf16_t*)(a.ws + WS_KV) + (size_t)1152 * 16384 + ((size_t)(b * 4 + h) * 18 + vb) * 16384;
#pragma unroll
    for (int nb = 0; nb < 8; ++nb) {
        f32x4 cf = (f32x4){0.f, 0.f, 0.f, 0.f}, cb = (f32x4){0.f, 0.f, 0.f, 0.f};
#pragma unroll
        for (int ks = 0; ks < 4; ++ks) {
            cf = __builtin_amdgcn_mfma_f32_16x16x32_bf16(af[ks], frag(B1, 16 * nb + fr, ks, fq), cf, 0, 0, 0);
            cb = __builtin_amdgcn_mfma_f32_16x16x32_bf16(af[ks], frag(B2, 16 * nb + fr, ks, fq), cb, 0, 0, 0);
        }
        const int off = (16 * nb + fr) * 128 + 16 * wid + 4 * fq;
        u32x2 w; w.x = cvt_pk(cf[0], cf[1]); w.y = cvt_pk(cf[2], cf[3]); *(u32x2*)(KVF + off) = w;
        w.x = cvt_pk(cb[0], cb[1]); w.y = cvt_pk(cb[2], cb[3]); *(u32x2*)(KVB + off) = w;
    }
    __syncthreads();
}

__device__ __forceinline__ void seq_tile(int idx, int& rowbase, int& L, int& t0) {
    if (idx < 512) { rowbase = (idx >> 5) * SEQ; L = SEQ; t0 = (idx & 31) * 64; } else { const int e = idx - 512; rowbase = ML + (e >> 2) * CTXL; L = CTXL; t0 = (e & 3) * 64; }
}

__device__ __forceinline__ void pool_item(const Args& a, int l, int idx, LAS unsigned char* lds, int tid, int lane, int wid) {
    int rowbase, L, t0; seq_tile(idx, rowbase, L, t0);
    const bf16_t* PB = (const bf16_t*)(a.ws + WS_HID); bf16_t* CAT = (bf16_t*)(a.ws + WS_H);
    LAS float* PT = (LAS float*)lds;
    LAS bf16_t* PL = (LAS bf16_t*)(lds + 81920);
    for (int i = tid; i < 80 * 32; i += 512) {
        const int rr = i >> 5, seg = i & 31, t = t0 - 8 + rr;
        u32x4 v = (u32x4){0u, 0u, 0u, 0u};
        if (t >= 0 && t < L) v = *(const u32x4*)(PB + (size_t)(rowbase + t) * PBW + seg * 8);
        LAS f32x4* d = (LAS f32x4*)(PT + rr * 256 + seg * 8);
        d[0] = (f32x4){bf_lo(v.x), bf_hi(v.x), bf_lo(v.y), bf_hi(v.y)}; d[1] = (f32x4){bf_lo(v.z), bf_hi(v.z), bf_lo(v.w), bf_hi(v.w)};
    }
    __syncthreads();
    {
        const int ch = tid & 255, th = tid >> 8, hw = 1 << (ch >> 6);
        for (int tt = 0; tt < 32; ++tt) {
            const int tl = th * 32 + tt, t = t0 + tl;
            const int lo = max(t - hw, 0), hi = min(t + hw, L);
            float s = 0.f;
            for (int uu = lo; uu < hi; ++uu) s += PT[(uu - t0 + 8) * 256 + ch];
            const float val = s / (float)(hi - lo) - PT[(tl + 8) * 256 + ch];
            PL[tl * 264 + ch] = (bf16_t)(cvt_pk(val, 0.f) & 0xffffu);
        }
    }
    __syncthreads();
    {
        const int g = wid >> 1, th = wid & 1, fr = lane & 15, fq = lane >> 4;
        const bf16_t* pwt = (const bf16_t*)(a.ws + WS_PWT) + (size_t)(l * 4 + g) * 4096;
        const float* psc = a.in[13] + l * 256 + g * 64;
#pragma unroll
        for (int tb = 0; tb < 2; ++tb) {
            const int tl = 32 * th + 16 * tb + fr;
            bf16x8 bfr[2];
#pragma unroll
            for (int ks = 0; ks < 2; ++ks) bfr[ks] = *(const LAS bf16x8*)((const LAS unsigned char*)PL + tl * 528 + (g * 64 + 32 * ks + 8 * fq) * 2);
#pragma unroll
            for (int mb = 0; mb < 4; ++mb) {
                f32x4 c = (f32x4){0.f, 0.f, 0.f, 0.f};
#pragma unroll
                for (int ks = 0; ks < 2; ++ks) { const bf16x8 af = *(const bf16x8*)(pwt + (16 * mb + fr) * 64 + 32 * ks + 8 * fq); c = __builtin_amdgcn_mfma_f32_16x16x32_bf16(af, bfr[ks], c, 0, 0, 0); }
                const f32x4 sc = *(const f32x4*)(psc + 16 * mb + 4 * fq); c = c * sc;
                u32x2 w; w.x = cvt_pk(c[0], c[1]); w.y = cvt_pk(c[2], c[3]);
                *(u32x2*)(CAT + (size_t)(rowbase + t0 + tl) * D + g * 64 + 16 * mb + 4 * fq) = w;
            }
        }
    }
    __syncthreads();
}

__device__ __forceinline__ void conv_item(const Args& a, int l, int idx, LAS unsigned char* lds, int tid, int lane, int wid) {
    int rowbase, L, t0; seq_tile(idx, rowbase, L, t0);
    const bf16_t* PB = (const bf16_t*)(a.ws + WS_HID); bf16_t* CAT = (bf16_t*)(a.ws + WS_H);
    LAS bf16_t* ZT = (LAS bf16_t*)lds;
    LAS float* CO = (LAS float*)(lds + 48128);
    for (int i = tid; i < 94 * 32; i += 512) {
        const int rr = i >> 5, seg = i & 31, t = t0 - 15 + rr;
        u32x4 v = (u32x4){0u, 0u, 0u, 0u};
        if (t >= 0 && t < L) v = *(const u32x4*)(PB + (size_t)(rowbase + t) * PBW + 2304 + seg * 8);
        *(LAS u32x4*)(lds + rr * 512 + seg * 16) = v;
    }
    __syncthreads();
    {
        const int c = tid & 255, th = tid >> 8;
        float zr[62];
#pragma unroll
        for (int uu = 0; uu < 62; ++uu) zr[uu] = __uint_as_float((unsigned)ZT[(32 * th + uu) * 256 + c] << 16);
        float acc[32]; const float bias = a.in[18][l * 256 + c];
#pragma unroll
        for (int t = 0; t < 32; ++t) acc[t] = bias;
        const float* dw = a.in[17] + (size_t)l * 31 * 256 + c;
#pragma unroll
        for (int k = 0; k < 31; ++k) {
            const float wk = dw[k * 256];
#pragma unroll
            for (int t = 0; t < 32; ++t) acc[t] += zr[t + k] * wk;
        }
#pragma unroll
        for (int t = 0; t < 32; ++t) CO[(32 * th + t) * 260 + c] = acc[t];
    }
    __syncthreads();
    {
        const f32x4 lg = *(const f32x4*)(a.in[19] + l * 256 + 4 * lane), lbv = *(const f32x4*)(a.in[20] + l * 256 + 4 * lane);
#pragma unroll
        for (int tt = 0; tt < 8; ++tt) {
            const int tl = 8 * wid + tt;
            const f32x4 v = *(const LAS f32x4*)(CO + tl * 260 + 4 * lane);
            const float mu = wave_sum((v.x + v.y) + (v.z + v.w)) * (1.f / 256.f);
            const f32x4 dv = v - mu;
            const float var = wave_sum((dv.x * dv.x + dv.y * dv.y) + (dv.z * dv.z + dv.w * dv.w)) * (1.f / 256.f);
            const float rstd = 1.f / sqrtf(var + EPS);
            const f32x4 y = dv * rstd * lg + lbv;
            u32x2 w; w.x = cvt_pk(silu_f(y.x), silu_f(y.y)); w.y = cvt_pk(silu_f(y.z), silu_f(y.w));
            *(u32x2*)(CAT + (size_t)(rowbase + t0 + tl) * D + 768 + 4 * lane) = w;
        }
    }
    __syncthreads();
}

__device__ __forceinline__ void scan_phase(const Args& a, int l, int tid, int bid, int G) {
    bf16_t* KV = (bf16_t*)(a.ws + WS_KV);
    for (int u = bid * 512 + tid; u < 262144; u += G * 512) {
        const int dir = u >> 17, bh = (u >> 11) & 63, e8 = u & 2047, h = bh & 3;
        bf16_t* base = KV + (size_t)dir * 1152 * 16384 + (size_t)bh * 18 * 16384 + e8 * 8;
        const float dec = exp2f(128.f * log2gamma(dir ? a.in[15] : a.in[14], l, h));
        float S[8];
#pragma unroll
        for (int i = 0; i < 8; ++i) S[i] = 0.f;
#pragma unroll 6
        for (int nn = 0; nn < 18; ++nn) {
            const int n = dir ? 17 - nn : nn;
            u32x4* p = (u32x4*)(base + (size_t)n * 16384);
            const u32x4 t = *p;
            u32x4 o; o.x = cvt_pk(S[0], S[1]); o.y = cvt_pk(S[2], S[3]); o.z = cvt_pk(S[4], S[5]); o.w = cvt_pk(S[6], S[7]);
            *p = o;
            S[0] = S[0] * dec + bf_lo(t.x); S[1] = S[1] * dec + bf_hi(t.x); S[2] = S[2] * dec + bf_lo(t.y); S[3] = S[3] * dec + bf_hi(t.y);
            S[4] = S[4] * dec + bf_lo(t.z); S[5] = S[5] * dec + bf_hi(t.z); S[6] = S[6] * dec + bf_lo(t.w); S[7] = S[7] * dec + bf_hi(t.w);
        }
    }
}

__device__ __forceinline__ void retout_item(const Args& a, int l, int b, int h, int vf, LAS unsigned char* lds, int tid, int lane, int wid) {
    int rows0, vb; chunk_rows(b, vf, rows0, vb);
    const bf16_t* PB = (const bf16_t*)(a.ws + WS_HID); bf16_t* CAT = (bf16_t*)(a.ws + WS_H);
    const bf16_t* Qs = PB + (size_t)rows0 * PBW + 256 + h * 128; const bf16_t* Ks = PB + (size_t)rows0 * PBW + 768 + h * 128;
    const bf16_t* Vs = PB + (size_t)rows0 * PBW + 1280 + h * 128; const bf16_t* Gs = PB + (size_t)rows0 * PBW + 1792 + h * 128;
    const bf16_t* SF = (const bf16_t*)(a.ws + WS_KV) + ((size_t)(b * 4 + h) * 18 + vf) * 16384;
    const bf16_t* SB = (const bf16_t*)(a.ws + WS_KV) + (size_t)1152 * 16384 + ((size_t)(b * 4 + h) * 18 + vb) * 16384;
    const float lf = log2gamma(a.in[14], l, h), lb = log2gamma(a.in[15], l, h);
    LAS unsigned char* B0 = lds; LAS unsigned char* B1 = lds + 34816; LAS unsigned char* B2 = lds + 69632; LAS unsigned char* PBUF = lds + 104448;
    const int fr = lane & 15, fq = lane >> 4, iloc = 16 * wid + fr;
    stage_rm(B0, Ks, PBW, tid);
    stage_tr(B1, Vs, PBW, tid, false, 0.f, 0.f);
    stage_rm(B2, SF, 128, tid);
    bf16x8 qa[4];
#pragma unroll
    for (int ks = 0; ks < 4; ++ks) qa[ks] = *(const bf16x8*)(Qs + (size_t)iloc * PBW + 32 * ks + 8 * fq);
    __syncthreads();
#pragma unroll
    for (int nb = 0; nb < 8; ++nb) {
        f32x4 c = (f32x4){0.f, 0.f, 0.f, 0.f};
#pragma unroll
        for (int ks = 0; ks < 4; ++ks) c = __builtin_amdgcn_mfma_f32_16x16x32_bf16(frag(B0, 16 * nb + fr, ks, fq), qa[ks], c, 0, 0, 0);
        float p[4];
#pragma unroll
        for (int r = 0; r < 4; ++r) { const int df = iloc - (16 * nb + 4 * fq + r); p[r] = c[r] * (df >= 0 ? exp2f((float)df * lf) : exp2f((float)(-df) * lb)); }
        u32x2 w; w.x = cvt_pk(p[0], p[1]); w.y = cvt_pk(p[2], p[3]);
        *(LAS u32x2*)(PBUF + iloc * TS + (16 * nb + 4 * fq) * 2) = w;
    }
    f32x4 O[8];
    const float wf = exp2f((float)(iloc + 1) * lf), wb = exp2f((float)(128 - iloc) * lb);
#pragma unroll
    for (int nb = 0; nb < 8; ++nb) {
        f32x4 c = (f32x4){0.f, 0.f, 0.f, 0.f};
#pragma unroll
        for (int ks = 0; ks < 4; ++ks) c = __builtin_amdgcn_mfma_f32_16x16x32_bf16(frag(B2, 16 * nb + fr, ks, fq), qa[ks], c, 0, 0, 0);
        O[nb] = c * wf;
    }
    __syncthreads();
    stage_rm(B0, SB, 128, tid);
    {
        bf16x8 pf[4];
#pragma unroll
        for (int ks = 0; ks < 4; ++ks) pf[ks] = frag(PBUF, iloc, ks, fq);
#pragma unroll
        for (int nb = 0; nb < 8; ++nb)
#pragma unroll
            for (int ks = 0; ks < 4; ++ks) O[nb] = __builtin_amdgcn_mfma_f32_16x16x32_bf16(frag(B1, 16 * nb + fr, ks, fq), pf[ks], O[nb], 0, 0, 0);
    }
    __syncthreads();
#pragma unroll
    for (int nb = 0; nb < 8; ++nb) {
        f32x4 c = (f32x4){0.f, 0.f, 0.f, 0.f};
#pragma unroll
        for (int ks = 0; ks < 4; ++ks) c = __builtin_amdgcn_mfma_f32_16x16x32_bf16(frag(B0, 16 * nb + fr, ks, fq), qa[ks], c, 0, 0, 0);
        O[nb] += c * wb;
    }
    float s = 0.f;
#pragma unroll
    for (int nb = 0; nb < 8; ++nb) s += (O[nb][0] + O[nb][1]) + (O[nb][2] + O[nb][3]);
    s += __shfl_xor(s, 16); s += __shfl_xor(s, 32);
    const float mu = s * (1.f / 128.f);
    float q = 0.f;
#pragma unroll
    for (int nb = 0; nb < 8; ++nb) { const f32x4 d = O[nb] - mu; q += (d[0] * d[0] + d[1] * d[1]) + (d[2] * d[2] + d[3] * d[3]); }
    q += __shfl_xor(q, 16); q += __shfl_xor(q, 32);
    const float rstd = 1.f / sqrtf(q * (1.f / 128.f) + EPS);
    const float* gn = a.in[16] + l * 512 + h * 128;
#pragma unroll
    for (int nb = 0; nb < 8; ++nb) {
        const int e0 = 16 * nb + 4 * fq;
        const u32x2 gv = *(const u32x2*)(Gs + (size_t)iloc * PBW + e0);
        const f32x4 gg = *(const f32x4*)(gn + e0);
        const f32x4 y = (O[nb] - mu) * rstd * gg;
        u32x2 w; w.x = cvt_pk(y[0] * silu_f(bf_lo(gv.x)), y[1] * silu_f(bf_hi(gv.x))); w.y = cvt_pk(y[2] * silu_f(bf_lo(gv.y)), y[3] * silu_f(bf_hi(gv.y)));
        *(u32x2*)(CAT + (size_t)(rows0 + iloc) * D + 256 + h * 128 + e0) = w;
    }
    __syncthreads();
}

__global__ void __launch_bounds__(512, 2) fwd_kernel(Args a) {
    extern __shared__ __attribute__((aligned(16))) unsigned char lds_raw[];
    LAS unsigned char* lds = (LAS unsigned char*)lds_raw;
    const int G = gridDim.x, bid = blockIdx.x;
    float* XC = (float*)(a.ws + WS_XC);
    bf16_t* Hb = (bf16_t*)(a.ws + WS_H);
    bf16_t* HID = (bf16_t*)(a.ws + WS_HID);
    const float* MXb = (const float*)(a.ws + WS_MX);

    for (int ph = a.ph_lo; ph < a.ph_hi; ++ph) {
#ifdef DUMP_PH
        if (ph > DUMP_PH) {
            if (ph == DUMP_PH + 1) {
                const bf16_t* src = (const bf16_t*)(a.ws + DUMP_SRC);
                for (size_t i = (size_t)bid * 512 + threadIdx.x; i < (size_t)ML * D; i += (size_t)G * 512) {
                    const int col = (int)(i & 1023);
                    a.out[i] = (col >= DUMP_C0 && col < DUMP_C1) ? __uint_as_float((unsigned)src[(i >> 10) * DUMP_LD + DUMP_CO + col] << 16) : 0.f;
                }
            }
            continue;
        }
#endif
        int tid_ = threadIdx.x; asm volatile("" : "+v"(tid_));
        const int tid = tid_, lane = tid & 63, wid = __builtin_amdgcn_readfirstlane(tid >> 6);
        if (ph == 0) { if (PHMASK & 1) prep_phase(a, lds, tid, bid, G); }
        else if (ph == NPH - 1) { if (PHMASK & 2) final_phase(a, lane, wid, bid, G); }
        else {
            const int l = (ph - 1) / 12, s = (ph - 1) % 12;
            if (!((SMASK >> s) & 1)) continue;
            const bool first = (l == 0), lastl = (l == 1);
            const bf16_t* WT = (const bf16_t*)(a.ws + WS_WT) + (size_t)l * WT_LAYER;
            if (s == 0 || s == 3 || s == 9) {
                const int sub = s == 0 ? 0 : (s == 3 ? 1 : 2);
                const bool in0 = first && s == 0;
                const int nrows = (lastl && s == 9) ? ML : MT;
                if (PHMASK & 4) norm_phase(a, l, sub, nrows, in0 ? a.in[0] : a.out, in0 ? a.in[2] : XC, lane, wid, bid, G);
            } else if (s == 1 || s == 10) {
                Gemm g{Hb, WT + (s == 1 ? WT_G1A : WT_G1B), D};
                Order S; S.init(((lastl && s == 10) ? ML : MT) / BM, (2 * DFF) / BM, G, bid);
                EpiSwiglu E{HID};
                if (PHMASK & 8) gemm_phase<EpiSwiglu, true>(lds, g, S, E);
            } else if (s == 2 || s == 8 || s == 11) {
                const bool in0 = first && s == 2;
                Gemm g{s == 8 ? Hb : HID, WT + (s == 2 ? WT_G2A : (s == 8 ? WT_WOUT : WT_G2B)), s == 8 ? D : DFF};
                Order S; S.init(((lastl && s != 2) ? ML : MT) / BM, D / BM, G, bid);
                EpiResid E{in0 ? a.in[0] : a.out, in0 ? a.in[2] : XC, a.out, XC, MXb + (size_t)l * 17 * 9216, (s == 2 ? 2 : (s == 8 ? 5 : 8)) * D, s == 8 ? 1.f : 0.5f};
                if (PHMASK & 16) gemm_phase<EpiResid, true>(lds, g, S, E);
            } else if (s == 4) {
                Gemm g{Hb, WT + WT_WIN, D};
                Order S; S.init((lastl ? ML : MT) / BM, INW / BM, G, bid);
                if (lastl) { S.xn = 64; S.xm0 = 128; S.xmn = 16; S.xn0 = 3; }
                EpiWin E{HID, (const float*)(a.ws + WS_ROPE), (const float*)(a.ws + WS_ROPE) + 2048};
                if (PHMASK & 32) gemm_phase<EpiWin, true>(lds, g, S, E);
            } else if (s == 5) {
                const int np = lastl ? 512 : 576;
                for (int it = bid; it < 1152 + 2 * np; it += G) {
                    if (it < 1152) { if (PHMASK & 64) kv_item(a, l, it, lds, tid, lane, wid); }
                    else if (it < 1152 + np) { if (PHMASK & 128) conv_item(a, l, it - 1152, lds, tid, lane, wid); }
                    else { if (PHMASK & 256) pool_item(a, l, it - 1152 - np, lds, tid, lane, wid); }
                }
            } else if (s == 6) {
                if (PHMASK & 512) scan_phase(a, l, tid, bid, G);
            } else if (s == 7) {
                const int nit = lastl ? 1024 : 1152;
                for (int it = bid; it < nit; it += G) {
                    int b, h, vf;
                    if (it < 1024) { b = it >> 6; h = (it >> 4) & 3; vf = 2 + (it & 15); } else { const int e = it - 1024; b = e >> 3; h = (e >> 1) & 3; vf = e & 1; }
                    if (PHMASK & 1024) retout_item(a, l, b, h, vf, lds, tid, lane, wid);
                }
            }
        }
        if (ph + 1 < a.ph_hi) cg::this_grid().sync();
    }
}

extern "C" void kernel_launch(void* const* d_in, const int* in_sizes, int n_in, void* d_out, int out_size, void* d_ws, size_t ws_size, hipStream_t stream) {
    static int grid = 0;
    if (grid == 0) {
        if (n_in != 22 || out_size != ML * D || ws_size < WS_END) { fprintf(stderr, "kernel_launch: unexpected shapes (n_in %d out %d ws %zu need %zu)\n", n_in, out_size, ws_size, (size_t)WS_END); grid = -1; return; }
        int dev = 0, cus = 0, per_cu = 0;
        hipGetDevice(&dev);
        hipDeviceGetAttribute(&cus, hipDeviceAttributeMultiprocessorCount, dev);
        if (hipFuncSetAttribute((const void*)fwd_kernel, hipFuncAttributeMaxDynamicSharedMemorySize, LDS_BYTES) != hipSuccess) { fprintf(stderr, "kernel_launch: hipFuncSetAttribute failed\n"); grid = -1; return; }
        hipOccupancyMaxActiveBlocksPerMultiprocessor(&per_cu, (const void*)fwd_kernel, 512, LDS_BYTES);
        if (per_cu < 1) { fprintf(stderr, "kernel_launch: occupancy query says %d blocks per CU\n", per_cu); per_cu = 1; }
        (void)hipGetLastError();
        grid = cus * 1;
    }
    if (grid < 0) return;
    Args a{};
    for (int i = 0; i < 22; ++i) a.in[i] = (const float*)d_in[i];
    a.out = (float*)d_out; a.ws = (unsigned char*)d_ws;
#if ONE_LAUNCH
    a.ph_lo = 0; a.ph_hi = NPH;
    void* args[] = {&a};
    hipError_t e = hipLaunchCooperativeKernel((const void*)fwd_kernel, dim3(grid), dim3(512), args, LDS_BYTES, stream);
    if (e != hipSuccess) fprintf(stderr, "cooperative launch failed: %s (grid %d)\n", hipGetErrorString(e), grid);
#else
    for (int ph = 0; ph < NPH; ++ph) {
        a.ph_lo = ph; a.ph_hi = ph + 1;
        hipLaunchKernelGGL(fwd_kernel, dim3(grid), dim3(512), LDS_BYTES, stream, a);
    }
#endif
}
```

```cpp
#include <hip/hip_runtime.h>
#include <hip/hip_cooperative_groups.h>
#include <cstdio>
#include <cstdint>
namespace cg = cooperative_groups;

#ifndef ONE_LAUNCH
#define ONE_LAUNCH 1
#endif

#define LAS __attribute__((address_space(3)))
typedef unsigned short bf16_t;
typedef short bf16x8 __attribute__((ext_vector_type(8)));
typedef float f32x4 __attribute__((ext_vector_type(4)));
typedef unsigned u32x4 __attribute__((ext_vector_type(4)));
typedef unsigned u32x2 __attribute__((ext_vector_type(2)));

constexpr int D = 1024, NB = 16, SEQ = 2048, CTXL = 256, DFF = 2816, INW = 2816;
constexpr int ML = NB * SEQ, MC = NB * CTXL, MT = ML + MC;
constexpr int PBW = 2560;
constexpr float EPS = 1e-6f;
constexpr int NPH = 26;
constexpr int LDS_BYTES = 147456;

constexpr size_t WS_MX = 4096;
constexpr size_t WS_ROPE = WS_MX + 1253376;
constexpr size_t WS_PWT = WS_ROPE + 16384;
constexpr size_t WS_BAR = WS_PWT + 65536;
constexpr size_t WS_DEC = WS_BAR + 16384;
constexpr size_t WS_WT = 2097152;
constexpr size_t WT_LAYER = 21233664;
constexpr size_t WT_G1A = 0, WT_G2A = 5767168, WT_WIN = 8650752, WT_WOUT = 11534336, WT_G1B = 12582912, WT_G2B = 18350080;
constexpr size_t WS_XC = WS_WT + 2 * WT_LAYER * 2;
constexpr size_t WS_H = WS_XC + (size_t)MC * D * 4;
constexpr size_t WS_HID = WS_H + (size_t)MT * D * 2;
constexpr size_t WS_KV = WS_HID + (size_t)MT * DFF * 2;
constexpr size_t WS_XP = WS_KV + (size_t)2 * 1152 * 16384 * 2;
constexpr size_t WS_END = WS_XP + (size_t)MC * D * 4;

struct Args { const float* in[22]; float* out; unsigned char* ws; int ph_lo, ph_hi; };
struct KA {
    const char* kb;
    __device__ __forceinline__ const float* in(int i) const { return *(const float* const*)(kb + 8 * i); }
    __device__ __forceinline__ float* out() const { return *(float* const*)(kb + 176); }
    __device__ __forceinline__ unsigned char* ws() const { return *(unsigned char* const*)(kb + 184); }
};

typedef float f32x2_t __attribute__((ext_vector_type(2)));
typedef __bf16 bf16x2_t __attribute__((ext_vector_type(2)));
__device__ __forceinline__ unsigned cvt_pk(float lo, float hi) { const f32x2_t v = {lo, hi}; const bf16x2_t b = __builtin_convertvector(v, bf16x2_t); return __builtin_bit_cast(unsigned, b); }
__device__ __forceinline__ float bf_lo(unsigned w) { return __uint_as_float(w << 16); }
__device__ __forceinline__ float bf_hi(unsigned w) { return __uint_as_float(w & 0xffff0000u); }
__device__ __forceinline__ float sigmoid_f(float x) { return __builtin_amdgcn_rcpf(1.f + __expf(-x)); }
__device__ __forceinline__ float silu_f(float x) { return x * sigmoid_f(x); }
__device__ __forceinline__ float wave_sum(float v) {
#pragma unroll
    for (int o = 1; o < 64; o <<= 1) v += __shfl_xor(v, o);
    return v;
}
__device__ __forceinline__ float log2gamma(const KA& a, int dir, int l, int h) { return ((const float*)(a.ws() + WS_DEC))[dir * 8 + l * 4 + h]; }

constexpr int BM = 256, BK = 64, HALF = 128, HTB = HALF * BK * 2, NXCD = 8, WGM = 8;
__device__ __forceinline__ int lds_byte(int r, int c) { const int st = (r >> 4) * 2 + (c >> 5), rr = r & 15, cc = c & 31, ob = rr * 64 + cc * 2; return st * 1024 + (ob ^ (((ob >> 9) & 1) << 5)); }
__device__ __forceinline__ void stage_rc(int b, int& R, int& C) { const int st = b / 1024, sb = b % 1024, swz = sb ^ (((sb >> 9) & 1) << 5); R = (st >> 1) * 16 + swz / 64; C = (st & 1) * 32 + (swz % 64) / 2; }
struct Unit { int pm, pn, kt0, nt, split; };
struct Gemm { const bf16_t* A; const bf16_t* Bt; int K; };
struct Order {
    int nM, nN, nwg, G, c, ntf, xn, xm0, xmn, xn0, xs;
    __device__ void init(int nM_, int nN_, int K_, int G_, int c_) { nM = nM_; nN = nN_; nwg = nM * nN; G = G_; c = c_; ntf = K_ / BK; xn = 0; xm0 = 0; xmn = 1; xn0 = 0; xs = 1; }
    __device__ bool next(int i, Unit& u) const {
        const long L = (long)i * G + c;
        if (L >= nwg) { const int e = (int)(L - nwg); if (e >= xn) return false; const int ue = e / xs, part = e % xs;
            u.pm = xm0 + ue % xmn; u.pn = xn0 + ue / xmn; u.nt = ntf / xs; u.kt0 = part * u.nt; u.split = (xs > 1); return true; }
        int wgid = (int)L; { const int q = nwg / NXCD, r = nwg % NXCD, xcd = wgid % NXCD, off = wgid / NXCD; wgid = (xcd < r ? xcd * (q + 1) : r * (q + 1) + (xcd - r) * q) + off; }
        const int nig = WGM * nN, gid = wgid / nig, fm = gid * WGM, gsz = (nM - fm) < WGM ? (nM - fm) : WGM;
        u.pm = fm + ((wgid % nig) % gsz); u.pn = (wgid % nig) / gsz; u.kt0 = 0; u.nt = ntf; u.split = 0; return true;
    }
};

struct EpiSwiglu {
    bf16_t* O;
    __device__ __forceinline__ void operator()(const f32x4 (&acc)[2][2][4][2], const Unit& u, int wr, int wc, int fr, int fq) const {
        const int row0 = u.pm * BM + wr * 64 + fr, col0 = u.pn * 128 + wc * 32 + 8 * fq;
#pragma unroll
        for (int ai = 0; ai < 2; ++ai)
#pragma unroll
            for (int m = 0; m < 4; ++m) {
                bf16_t* p = O + (size_t)(row0 + ai * HALF + m * 16) * DFF + col0;
                const f32x4 a0 = acc[ai][0][m][0], a1 = acc[ai][0][m][1], b0 = acc[ai][1][m][0], b1 = acc[ai][1][m][1];
                u32x4 w;
                w.x = cvt_pk(silu_f(a0[0]) * b0[0], silu_f(a0[1]) * b0[1]); w.y = cvt_pk(silu_f(a0[2]) * b0[2], silu_f(a0[3]) * b0[3]);
                w.z = cvt_pk(silu_f(a1[0]) * b1[0], silu_f(a1[1]) * b1[1]); w.w = cvt_pk(silu_f(a1[2]) * b1[2], silu_f(a1[3]) * b1[3]);
                *(u32x4*)p = w;
            }
    }
};
struct EpiResid {
    const float* res_lat; const float* res_ctx; float* out_lat; float* out_ctx; float* xp; const float* mx; int gate_off; float coef;
    __device__ __forceinline__ void operator()(const f32x4 (&acc)[2][2][4][2], const Unit& u, int wr, int wc, int fr, int fq) const {
        const bool lat = u.pm < 128; const int b = lat ? (u.pm >> 3) : 16;
        const float* res = lat ? res_lat + (size_t)u.pm * BM * D : res_ctx + (size_t)(u.pm - 128) * BM * D;
        float* out = lat ? out_lat + (size_t)u.pm * BM * D : out_ctx + (size_t)(u.pm - 128) * BM * D;
        const int col0 = u.pn * BM + wc * 32 + 4 * fq;
        const float* gp = mx + b * 9216 + gate_off + col0;
        const bool side = (u.kt0 != 0);
        f32x4 g[2][2];
#pragma unroll
        for (int bj = 0; bj < 2; ++bj)
#pragma unroll
            for (int n = 0; n < 2; ++n) g[bj][n] = *(const f32x4*)(gp + bj * HALF + n * 16);
        asm volatile("" ::: "memory");
#pragma unroll
        for (int bj = 0; bj < 2; ++bj)
#pragma unroll
            for (int n = 0; n < 2; ++n) g[bj][n] = g[bj][n] * coef;
        const unsigned rowoff = (unsigned)((wr * 64 + fr) * D + col0);
        if (side) {
            float* xq = xp + (size_t)(u.pm - 128) * BM * D;
#pragma unroll
            for (int grp = 0; grp < 8; ++grp) {
                const int ai = grp >> 2, m = grp & 3; const unsigned off = rowoff + (unsigned)((ai * HALF + m * 16) * D);
#pragma unroll
                for (int bj = 0; bj < 2; ++bj)
#pragma unroll
                    for (int n = 0; n < 2; ++n) *(f32x4*)(xq + off + bj * HALF + n * 16) = g[bj][n] * acc[ai][bj][m][n];
            }
            return;
        }
        f32x4 r0[2][2], r1[2][2], r2[2][2];
#pragma unroll
        for (int bj = 0; bj < 2; ++bj)
#pragma unroll
            for (int n = 0; n < 2; ++n) { r0[bj][n] = *(const f32x4*)(res + rowoff + bj * HALF + n * 16); r1[bj][n] = *(const f32x4*)(res + rowoff + 16 * D + bj * HALF + n * 16); }
#pragma unroll
        for (int grp = 0; grp < 8; ++grp) {
            const int ai = grp >> 2, m = grp & 3;
            const unsigned off = rowoff + (unsigned)((ai * HALF + m * 16) * D);
            if (grp < 6) {
                const unsigned offn = rowoff + (unsigned)((((grp + 2) >> 2) * HALF + ((grp + 2) & 3) * 16) * D);
#pragma unroll
                for (int bj = 0; bj < 2; ++bj)
#pragma unroll
                    for (int n = 0; n < 2; ++n) r2[bj][n] = *(const f32x4*)(res + offn + bj * HALF + n * 16);
            }
#pragma unroll
            for (int bj = 0; bj < 2; ++bj)
#pragma unroll
                for (int n = 0; n < 2; ++n) *(f32x4*)(out + off + bj * HALF + n * 16) = r0[bj][n] + g[bj][n] * acc[ai][bj][m][n];
#pragma unroll
            for (int bj = 0; bj < 2; ++bj)
#pragma unroll
                for (int n = 0; n < 2; ++n) { r0[bj][n] = r1[bj][n]; r1[bj][n] = r2[bj][n]; }
        }
    }
};
struct EpiWin {
    bf16_t* PB; const float* rc; const float* rs;
    __device__ __forceinline__ void operator()(const f32x4 (&acc)[2][2][4][2], const Unit& u, int wr, int wc, int fr, int fq) const {
        const int pn = u.pn, rowb = u.pm * BM + wr * 64 + fr;
        if (pn >= 1 && pn <= 4) {
            const bool lat = u.pm < 128; const float ksc = (pn >= 3) ? 0.08838834764831845f : 1.f;
            const int s = wc >> 1, f0 = 16 * (wc & 1) + 4 * fq;
            f32x4 csn = (f32x4){1.f, 1.f, 1.f, 1.f}, snn = (f32x4){0.f, 0.f, 0.f, 0.f};
            if (lat) { const int t = rowb & 2047, pos = s ? (t & 63) : (t >> 6); csn = *(const f32x4*)(rc + pos * 32 + f0); snn = *(const f32x4*)(rs + pos * 32 + f0); }
#pragma unroll
            for (int grp = 0; grp < 8; ++grp) {
                const int ai = grp >> 2, m = grp & 3;
                const int r = rowb + ai * HALF + m * 16;
                const f32x4 cs = csn * ksc, sn = snn * ksc;
                if (lat && grp < 7) { const int rn = rowb + ((grp + 1) >> 2) * HALF + ((grp + 1) & 3) * 16, t = rn & 2047, pos = s ? (t & 63) : (t >> 6);
                    csn = *(const f32x4*)(rc + pos * 32 + f0); snn = *(const f32x4*)(rs + pos * 32 + f0); }
#pragma unroll
                for (int bj = 0; bj < 2; ++bj) {
                    const f32x4 u1 = acc[ai][bj][m][0], u2 = acc[ai][bj][m][1];
                    const f32x4 o1 = u1 * cs - u2 * sn, o2 = u1 * sn + u2 * cs;
                    bf16_t* p = PB + (size_t)r * PBW + 256 * pn + 128 * bj + 64 * s + f0;
                    u32x2 w1, w2; w1.x = cvt_pk(o1[0], o1[1]); w1.y = cvt_pk(o1[2], o1[3]); w2.x = cvt_pk(o2[0], o2[1]); w2.y = cvt_pk(o2[2], o2[3]);
                    *(u32x2*)p = w1; *(u32x2*)(p + 32) = w2;
                }
            }
        } else if (pn >= 9) {
            const int col0 = 2304 + 128 * (pn - 9) + wc * 32 + 8 * fq;
#pragma unroll
            for (int ai = 0; ai < 2; ++ai)
#pragma unroll
                for (int m = 0; m < 4; ++m) {
                    const int r = rowb + ai * HALF + m * 16;
                    const f32x4 a0 = acc[ai][0][m][0], a1 = acc[ai][0][m][1], g0 = acc[ai][1][m][0], g1 = acc[ai][1][m][1];
                    u32x4 w;
                    w.x = cvt_pk(a0[0] * sigmoid_f(g0[0]), a0[1] * sigmoid_f(g0[1])); w.y = cvt_pk(a0[2] * sigmoid_f(g0[2]), a0[3] * sigmoid_f(g0[3]));
                    w.z = cvt_pk(a1[0] * sigmoid_f(g1[0]), a1[1] * sigmoid_f(g1[1])); w.w = cvt_pk(a1[2] * sigmoid_f(g1[2]), a1[3] * sigmoid_f(g1[3]));
                    *(u32x4*)(PB + (size_t)r * PBW + col0) = w;
                }
        } else {
            const int col0 = 256 * pn + wc * 32 + 8 * fq;
#pragma unroll
            for (int ai = 0; ai < 2; ++ai)
#pragma unroll
                for (int m = 0; m < 4; ++m) {
                    const int r = rowb + ai * HALF + m * 16;
#pragma unroll
                    for (int bj = 0; bj < 2; ++bj) {
                        const f32x4 v0 = acc[ai][bj][m][0], v1 = acc[ai][bj][m][1];
                        u32x4 w; w.x = cvt_pk(v0[0], v0[1]); w.y = cvt_pk(v0[2], v0[3]); w.z = cvt_pk(v1[0], v1[1]); w.w = cvt_pk(v1[2], v1[3]);
                        *(u32x4*)(PB + (size_t)r * PBW + col0 + 128 * bj) = w;
                    }
                }
        }
    }
};

template <class Epi, bool ALIGN_EPI>
__device__ __forceinline__ void gemm_phase(LAS unsigned char* lds, const Gemm g, const Order& S, const Epi& E) {
    int tid_ = threadIdx.x; asm volatile("" : "+v"(tid_));
    const int tid = tid_, wid = __builtin_amdgcn_readfirstlane(tid >> 6), lane = tid & 63, wr = wid >> 2, wc = wid & 3, fr = lane & 15, fq = lane >> 4;
    const int K = g.K;
    unsigned voff[2];
#pragma unroll
    for (int i = 0; i < 2; ++i) { int R, C; stage_rc(tid * 16 + i * 8192, R, C); voff[i] = (unsigned)(R * K + C) * 2u; }
    const size_t kstep = (size_t)(BK * 2);
    const size_t hstep = (size_t)HALF * K * 2;
    const size_t tstep = 2 * hstep;
    const unsigned ldsw = (unsigned)wid * 1024u;
    const int aoff = lds_byte(wr * 64 + fr, fq * 8), boff = lds_byte(wc * 32 + fr, fq * 8);
#define PG8_SA(b, h) (((b) * 2 + (h)) * HTB)
#define PG8_SB(b, h) ((4 + (b) * 2 + (h)) * HTB)
#define PG8_STAGE(bufoff, gbase) do { _Pragma("unroll") for (int _i = 0; _i < 2; ++_i) \
        __builtin_amdgcn_global_load_lds((const unsigned*)((const char*)(gbase) + voff[_i]), (LAS unsigned*)(lds + (bufoff) + ldsw + _i * 8192), 16, 0, 0); } while (0)
#define PG8_LDA(dst, b, h) do { _Pragma("unroll") for (int m = 0; m < 4; ++m) _Pragma("unroll") for (int k = 0; k < 2; ++k) dst[m][k] = *(const LAS bf16x8*)(lds + PG8_SA(b, h) + aoff + m * 2048 + k * 1024); } while (0)
#define PG8_LDB(dst, b, h) do { _Pragma("unroll") for (int n = 0; n < 2; ++n) _Pragma("unroll") for (int k = 0; k < 2; ++k) dst[n][k] = *(const LAS bf16x8*)(lds + PG8_SB(b, h) + boff + n * 2048 + k * 1024); } while (0)
#define PG8_MMA(ai, bj, At, Bt) do { __builtin_amdgcn_s_setprio(1); _Pragma("unroll") for (int m = 0; m < 4; ++m) _Pragma("unroll") for (int n = 0; n < 2; ++n) _Pragma("unroll") for (int k = 0; k < 2; ++k) \
        acc[ai][bj][m][n] = __builtin_amdgcn_mfma_f32_16x16x32_bf16(Bt[n][k], At[m][k], acc[ai][bj][m][n], 0, 0, 0); __builtin_amdgcn_s_setprio(0); } while (0)
#define PG8_WAIT_V(n) asm volatile("s_waitcnt vmcnt(" #n ")" ::: "memory")
#define PG8_WAIT_L(n) asm volatile("s_waitcnt lgkmcnt(" #n ")" ::: "memory")
#define PG8_BAR __builtin_amdgcn_s_barrier()
#define PG8_SCHED __builtin_amdgcn_sched_barrier(0)
    Unit cur, nxt; int ui = 0;
    if (!S.next(0, cur)) return;
    f32x4 acc[2][2][4][2];
#pragma unroll
    for (int a = 0; a < 2; ++a)
#pragma unroll
        for (int b = 0; b < 2; ++b)
#pragma unroll
            for (int m = 0; m < 4; ++m)
#pragma unroll
                for (int n = 0; n < 2; ++n) acc[a][b][m][n] = (f32x4){0.f, 0.f, 0.f, 0.f};
    bf16x8 At[4][2], B0[2][2], B1[2][2];
    const char* cA = (const char*)g.A + (size_t)cur.pm * tstep + (size_t)cur.kt0 * kstep; const char* cB = (const char*)g.Bt + (size_t)cur.pn * tstep + (size_t)cur.kt0 * kstep;
    PG8_STAGE(PG8_SB(0, 0), cB); PG8_STAGE(PG8_SB(0, 1), cB + hstep); PG8_STAGE(PG8_SA(0, 0), cA); PG8_STAGE(PG8_SA(0, 1), cA + hstep);
    if (wr == 1) PG8_BAR;
    PG8_WAIT_V(2); PG8_BAR;
    PG8_STAGE(PG8_SB(1, 0), cB + kstep); PG8_STAGE(PG8_SA(1, 0), cA + kstep); PG8_STAGE(PG8_SB(1, 1), cB + hstep + kstep);
    PG8_WAIT_V(6); PG8_BAR;
    for (;;) {
        const bool has_next = S.next(ui + 1, nxt);
        const char* nA = has_next ? (const char*)g.A + (size_t)nxt.pm * tstep + (size_t)nxt.kt0 * kstep : cA; const char* nB = has_next ? (const char*)g.Bt + (size_t)nxt.pn * tstep + (size_t)nxt.kt0 * kstep : cB;
        const int nt = cur.nt;
        for (int t = 0; t < nt; t += 2) {
            const bool last = (t == nt - 2);
            const char* a1 = cA + (size_t)(t + 1) * kstep;
            const char* a2 = last ? nA : cA + (size_t)(t + 2) * kstep; const char* b2 = last ? nB : cB + (size_t)(t + 2) * kstep;
            const char* a3 = a2 + kstep; const char* b3 = b2 + kstep;
            PG8_LDB(B0, 0, 0); PG8_LDB(B1, 0, 1); PG8_SCHED; PG8_LDA(At, 0, 0); PG8_STAGE(PG8_SA(1, 1), a1 + hstep);
            PG8_WAIT_V(8); PG8_WAIT_L(0); PG8_BAR; PG8_MMA(0, 0, At, B0); PG8_MMA(0, 1, At, B1); PG8_BAR; PG8_SCHED;
            PG8_LDA(At, 0, 1); PG8_STAGE(PG8_SB(0, 0), b2); PG8_STAGE(PG8_SB(0, 1), b2 + hstep); PG8_STAGE(PG8_SA(0, 0), a2);
            PG8_WAIT_V(8); PG8_WAIT_L(0); PG8_BAR; PG8_MMA(1, 0, At, B0); PG8_MMA(1, 1, At, B1); PG8_BAR; PG8_SCHED;
            PG8_LDB(B0, 1, 0); PG8_LDB(B1, 1, 1); PG8_SCHED; PG8_LDA(At, 1, 0); PG8_STAGE(PG8_SA(0, 1), a2 + hstep);
            PG8_WAIT_V(8); PG8_WAIT_L(0); PG8_BAR; PG8_MMA(0, 0, At, B0); PG8_MMA(0, 1, At, B1); PG8_BAR; PG8_SCHED;
            PG8_LDA(At, 1, 1); PG8_STAGE(PG8_SB(1, 0), b3); PG8_STAGE(PG8_SB(1, 1), b3 + hstep); PG8_STAGE(PG8_SA(1, 0), a3);
            PG8_WAIT_V(8); PG8_WAIT_L(0); PG8_BAR; PG8_MMA(1, 0, At, B0); PG8_MMA(1, 1, At, B1); PG8_BAR; PG8_SCHED;
        }
        if constexpr (ALIGN_EPI) { if (wr == 0) PG8_BAR; }
        E(acc, cur, wr, wc, fr, fq);
        if (!has_next) break;
#pragma unroll
        for (int a = 0; a < 2; ++a)
#pragma unroll
            for (int b = 0; b < 2; ++b)
#pragma unroll
                for (int m = 0; m < 4; ++m)
#pragma unroll
                    for (int n = 0; n < 2; ++n) acc[a][b][m][n] = (f32x4){0.f, 0.f, 0.f, 0.f};
        cur = nxt; cA = nA; cB = nB; ++ui;
        if constexpr (ALIGN_EPI) { if (wr == 1) PG8_BAR; }
    }
    PG8_WAIT_V(0);
    if constexpr (!ALIGN_EPI) { if (wr == 0) PG8_BAR; }
    PG8_BAR;
#undef PG8_SA
#undef PG8_SB
#undef PG8_STAGE
#undef PG8_LDA
#undef PG8_LDB
#undef PG8_MMA
#undef PG8_WAIT_V
#undef PG8_WAIT_L
#undef PG8_BAR
#undef PG8_SCHED
}

__device__ __forceinline__ const float* wsrc(const KA& a, int l, int mat, int rho, int& ldw) {
    const int j = rho & 3, fq = (rho >> 2) & 3, n = (rho >> 4) & 1, wc = (rho >> 5) & 3, bj = (rho >> 7) & 1, pn = rho >> 8;
    const int p8 = 8 * fq + 4 * n + j;
    if (mat == 0 || mat == 4) { const int s = (mat == 4); ldw = DFF; return (bj ? a.in(8) : a.in(7)) + (size_t)(l * 2 + s) * D * DFF + (128 * pn + 32 * wc + p8); }
    if (mat == 1 || mat == 5) { const int s = (mat == 5); ldw = D; return a.in(9) + (size_t)(l * 2 + s) * DFF * D + rho; }
    if (mat == 3) { ldw = D; return a.in(11) + (size_t)l * D * D + rho; }
    ldw = INW; int c;
    if (pn >= 1 && pn <= 4) { const int hh = 2 * ((pn - 1) & 1) + bj; c = (pn < 3 ? 256 : 768) + hh * 128 + 64 * (wc >> 1) + 32 * n + 16 * (wc & 1) + 4 * fq + j; }
    else if (pn >= 9) c = 2304 + 256 * bj + 128 * (pn - 9) + 32 * wc + p8;
    else c = (rho & ~31) + p8;
    return a.in(10) + (size_t)l * D * INW + c;
}

__device__ __forceinline__ void prep_phase(const KA& a, LAS unsigned char* lds, int tid, int bid, int G) {
    constexpr int N_MOD = 288;
    float* MX = (float*)(a.ws() + WS_MX);
    for (int it = bid; it < N_MOD + 2; it += G) {
        if (it < N_MOD) {
            const int l = it / 144, n0 = (it % 144) * 64;
            LAS float* Sv = (LAS float*)lds;
            LAS float* RED = (LAS float*)(lds + 69632);
            for (int idx = tid; idx < 17 * 1024; idx += 512) { const int r = idx >> 10, k = idx & 1023; const float v = r < 16 ? a.in(1)[r * 1024 + k] : a.in(3)[k]; Sv[idx] = v / (1.f + __expf(-v)); }
            __syncthreads();
            const int ks = tid >> 6, col = tid & 63;
            float acc[17];
#pragma unroll
            for (int r = 0; r < 17; ++r) acc[r] = 0.f;
            const float* wp = a.in(4) + ((size_t)l * 1024 + ks * 128) * 9216 + n0 + col;
            float w[16];
#pragma unroll
            for (int u = 0; u < 16; ++u) w[u] = __builtin_nontemporal_load(wp + (size_t)u * 9216);
            for (int k16 = 0; k16 < 128; k16 += 16) {
                float wn[16];
                const int kn = (k16 + 16 < 128) ? k16 + 16 : k16;
#pragma unroll
                for (int u = 0; u < 16; ++u) wn[u] = __builtin_nontemporal_load(wp + (size_t)(kn + u) * 9216);
#pragma unroll
                for (int u = 0; u < 16; ++u)
#pragma unroll
                    for (int r = 0; r < 17; ++r) acc[r] += Sv[r * 1024 + ks * 128 + k16 + u] * w[u];
#pragma unroll
                for (int u = 0; u < 16; ++u) w[u] = wn[u];
            }
#pragma unroll
            for (int r = 0; r < 17; ++r) RED[(ks * 17 + r) * 64 + col] = acc[r];
            __syncthreads();
            for (int idx = tid; idx < 17 * 64; idx += 512) {
                const int r = idx >> 6, c2 = idx & 63; float s = a.in(5)[l * 9216 + n0 + c2];
#pragma unroll
                for (int k8 = 0; k8 < 8; ++k8) s += RED[(k8 * 17 + r) * 64 + c2];
                MX[(size_t)(l * 17 + r) * 9216 + n0 + c2] = s;
            }
            __syncthreads();
        } else if (it == N_MOD) {
            float* rc = (float*)(a.ws() + WS_ROPE); float* rs = rc + 2048;
            for (int idx = tid; idx < 2048; idx += 512) { const int pos = idx >> 5, f = idx & 31; const float inv = __builtin_amdgcn_exp2f(-(float)f * 0.41524101186092029f);
                const float ang = (float)pos * inv; rc[idx] = __cosf(ang); rs[idx] = __sinf(ang); }
            if (tid < 16) { const int dir = tid >> 3, lh = tid & 7; const float x = (dir ? a.in(15) : a.in(14))[lh]; ((float*)(a.ws() + WS_DEC))[tid] = -__log2f(1.f + __expf(-x)); }
        } else {
            bf16_t* pwt = (bf16_t*)(a.ws() + WS_PWT);
            for (int idx = tid; idx < 2 * 4 * 64 * 64; idx += 512) { const int c = idx & 63, d = (idx >> 6) & 63, lg = idx >> 12; pwt[idx] = (bf16_t)(cvt_pk(a.in(12)[(lg * 64 + c) * 64 + d], 0.f) & 0xffffu); }
        }
    }
    {
        const int lane = tid & 63, wv = __builtin_amdgcn_readfirstlane(tid >> 6);
        LAS bf16_t* T = (LAS bf16_t*)(lds + 110592 + wv * 4224);
        const int cg4 = lane & 7, kr = lane >> 3;
#define TR_DECODE(t_, src_, ldw_, dstrow_, K_, k0_) do { const int l_ = (t_) / 10368; int r_ = (t_) % 10368; int mat_; size_t moff_; \
            if (r_ < 2816) { mat_ = 0; moff_ = WT_G1A; } else if (r_ < 4224) { mat_ = 1; r_ -= 2816; moff_ = WT_G2A; } else if (r_ < 5632) { mat_ = 2; r_ -= 4224; moff_ = WT_WIN; } \
            else if (r_ < 6144) { mat_ = 3; r_ -= 5632; moff_ = WT_WOUT; } else if (r_ < 8960) { mat_ = 4; r_ -= 6144; moff_ = WT_G1B; } else { mat_ = 5; r_ -= 8960; moff_ = WT_G2B; } \
            K_ = (mat_ == 1 || mat_ == 5) ? DFF : D; const int nrt_ = (mat_ == 0 || mat_ == 4) ? 176 : (mat_ == 2 ? 88 : 32), kt_ = r_ / nrt_, rt_ = r_ % nrt_; k0_ = kt_ * 64; \
            src_ = wsrc(a, l_, mat_, rt_ * 32 + 4 * cg4, ldw_); dstrow_ = (bf16_t*)(a.ws() + WS_WT) + (size_t)l_ * WT_LAYER + moff_ + (size_t)(rt_ * 32) * K_; } while (0)
        int t = bid * 8 + wv;
        if (t < 20736) {
            const float* src; int ldw, K, k0; bf16_t* dstrow;
            TR_DECODE(t, src, ldw, dstrow, K, k0);
            f32x4 v[8];
#pragma unroll
            for (int i = 0; i < 8; ++i) v[i] = __builtin_nontemporal_load((const f32x4*)(src + (size_t)(k0 + kr + 8 * i) * ldw));
            for (;;) {
                const int tn = t + G * 8; const bool hasN = tn < 20736;
                const float* srcn = src; int ldwn = ldw, Kn = K, k0n = k0; bf16_t* dstrown = dstrow;
                f32x4 vn[8];
                if (hasN) { TR_DECODE(tn, srcn, ldwn, dstrown, Kn, k0n);
#pragma unroll
                    for (int i = 0; i < 8; ++i) vn[i] = __builtin_nontemporal_load((const f32x4*)(srcn + (size_t)(k0n + kr + 8 * i) * ldwn)); }
#pragma unroll
                for (int i = 0; i < 8; ++i)
#pragma unroll
                    for (int j = 0; j < 4; ++j) T[(4 * cg4 + j) * 66 + kr + 8 * i] = (bf16_t)(cvt_pk(v[i][j], 0.f) & 0xffffu);
                asm volatile("s_waitcnt lgkmcnt(0)" ::: "memory");
                const int r2 = lane >> 1, hf = lane & 1;
                const LAS unsigned* tp = (const LAS unsigned*)((const LAS unsigned char*)T + r2 * 132 + hf * 64);
                bf16_t* dst = dstrow + (size_t)r2 * K + k0 + hf * 32;
#pragma unroll
                for (int q = 0; q < 4; ++q) { u32x4 o; o.x = tp[4 * q]; o.y = tp[4 * q + 1]; o.z = tp[4 * q + 2]; o.w = tp[4 * q + 3]; *(u32x4*)(dst + 8 * q) = o; }
                asm volatile("s_waitcnt lgkmcnt(0)" ::: "memory");
                if (!hasN) break;
#pragma unroll
                for (int i = 0; i < 8; ++i) v[i] = vn[i];
                t = tn; src = srcn; ldw = ldwn; K = Kn; k0 = k0n; dstrow = dstrown;
            }
        }
#undef TR_DECODE
    }
}

__device__ __forceinline__ void norm_load(const KA& a, int row, const float* xl, const float* xc, bool addp, int lane, f32x4 (&v)[4]) {
    const bool lat = row < ML;
    const f32x4* xr = (const f32x4*)(lat ? xl + (size_t)row * D : xc + (size_t)(row - ML) * D) + lane;
#pragma unroll
    for (int j = 0; j < 4; ++j) v[j] = xr[64 * j];
    if (!lat && addp) {
        const f32x4* pr = (const f32x4*)(a.ws() + WS_XP + (size_t)(row - ML) * D * 4) + lane; f32x4* xw = (f32x4*)(a.ws() + WS_XC + (size_t)(row - ML) * D * 4) + lane;
#pragma unroll
        for (int j = 0; j < 4; ++j) { v[j] += pr[64 * j]; xw[64 * j] = v[j]; }
    }
}
struct NormPar { f32x4 sh[4], sc[4]; };
__device__ __forceinline__ void norm_params(const KA& a, int l, int s, int b, int lane, NormPar& P) {
    const float* mp = (const float*)(a.ws() + WS_MX) + (size_t)(l * 17 + b) * 9216 + (3 * s) * D;
#pragma unroll
    for (int j = 0; j < 4; ++j) { const int col = 256 * j + 4 * lane; P.sh[j] = *(const f32x4*)(mp + col); P.sc[j] = *(const f32x4*)(mp + D + col); }
}
__device__ __forceinline__ void norm_finish(const KA& a, int row, int lane, const f32x4 (&v)[4], const f32x4 (&g)[4], const NormPar& P) {
    bf16_t* H = (bf16_t*)(a.ws() + WS_H);
    float ss = 0.f;
#pragma unroll
    for (int j = 0; j < 4; ++j) ss += (v[j].x * v[j].x + v[j].y * v[j].y) + (v[j].z * v[j].z + v[j].w * v[j].w);
    const float rstd = 1.f / sqrtf(wave_sum(ss) * (1.f / D) + EPS);
    u32x2* o8 = (u32x2*)(H + (size_t)row * D) + lane;
#pragma unroll
    for (int j = 0; j < 4; ++j) {
        const f32x4 h = (v[j] * rstd * g[j]) * (P.sc[j] + 1.f) + P.sh[j];
        u32x2 w; w.x = cvt_pk(h.x, h.y); w.y = cvt_pk(h.z, h.w); o8[64 * j] = w;
    }
}
__device__ __forceinline__ int norm_row(int gw, int k, bool fast, int rpw) { return fast ? (k < 16 ? ((gw >> 7) << 11) + (gw & 127) + (k << 7) : ML + gw + ((k - 16) << 11)) : gw * rpw + k; }
__device__ __forceinline__ void norm_phase(const KA& a, int l, int s, int nrows, const float* xl, const float* xc, bool addp, int lane, int wid, int bid, int G) {
    const int NW = G * 8, gw = bid * 8 + wid; const bool fast = (NW == 2048);
    const int rpw = (nrows + NW - 1) / NW;
    const int nk = fast ? (nrows > ML ? 18 : 16) : max(0, min(rpw, nrows - gw * rpw));
    if (nk <= 0) return;
    f32x4 g[4];
    { const float* gp = a.in(6) + (l * 3 + s) * D;
#pragma unroll
      for (int j = 0; j < 4; ++j) g[j] = *(const f32x4*)(gp + 256 * j + 4 * lane); }
    int k = 0, row = norm_row(gw, 0, fast, rpw), rowB = norm_row(gw, 1, fast, rpw);
    int bcur = row < ML ? (row >> 11) : 16;
    NormPar P; norm_params(a, l, s, bcur, lane, P);
    bool hasB = 1 < nk;
    f32x4 va[4], vb[4];
    norm_load(a, row, xl, xc, addp, lane, va);
    if (hasB) norm_load(a, rowB, xl, xc, addp, lane, vb);
    for (;;) {
        const bool hasN = k + 2 < nk, hasNB = k + 3 < nk;
        const int nrow = norm_row(gw, k + 2, fast, rpw), nrowB = norm_row(gw, k + 3, fast, rpw);
        f32x4 na[4], nb[4];
        if (hasN) norm_load(a, nrow, xl, xc, addp, lane, na);
        if (hasNB) norm_load(a, nrowB, xl, xc, addp, lane, nb);
        { const int b0 = row < ML ? (row >> 11) : 16; if (b0 != bcur) { bcur = b0; norm_params(a, l, s, bcur, lane, P); } }
        norm_finish(a, row, lane, va, g, P);
        if (hasB) { const int b1 = rowB < ML ? (rowB >> 11) : 16; if (b1 != bcur) { bcur = b1; norm_params(a, l, s, bcur, lane, P); }
            norm_finish(a, rowB, lane, vb, g, P); }
        if (!hasN) break;
#pragma unroll
        for (int j = 0; j < 4; ++j) { va[j] = na[j]; vb[j] = nb[j]; }
        k += 2; row = nrow; rowB = nrowB; hasB = hasNB;
    }
}
__device__ __forceinline__ void final_phase(const KA& a, int lane, int wid, int bid, int G) {
    const int stride = G * 8;
    int row = bid * 8 + wid; if (row >= ML) return;
    f32x4 g[4];
#pragma unroll
    for (int j = 0; j < 4; ++j) g[j] = *(const f32x4*)(a.in(21) + 256 * j + 4 * lane);
    bool hasB = row + stride < ML;
    f32x4 va[4], vb[4];
    { const f32x4* xa = (const f32x4*)(a.out() + (size_t)row * D) + lane; const f32x4* xb = (const f32x4*)(a.out() + (size_t)(hasB ? row + stride : row) * D) + lane;
#pragma unroll
      for (int j = 0; j < 4; ++j) { va[j] = xa[64 * j]; vb[j] = xb[64 * j]; } }
    for (;;) {
        const int nrow = row + 2 * stride; const bool hasN = nrow < ML, hasNB = nrow + stride < ML;
        f32x4 na[4], nb[4];
        { const f32x4* xa = (const f32x4*)(a.out() + (size_t)(hasN ? nrow : row) * D) + lane; const f32x4* xb = (const f32x4*)(a.out() + (size_t)(hasNB ? nrow + stride : row) * D) + lane;
#pragma unroll
          for (int j = 0; j < 4; ++j) { na[j] = xa[64 * j]; nb[j] = xb[64 * j]; } }
        float sa = 0.f, sb = 0.f;
#pragma unroll
        for (int j = 0; j < 4; ++j) { sa += (va[j].x * va[j].x + va[j].y * va[j].y) + (va[j].z * va[j].z + va[j].w * va[j].w); sb += (vb[j].x * vb[j].x + vb[j].y * vb[j].y) + (vb[j].z * vb[j].z + vb[j].w * vb[j].w); }
        const float ra = 1.f / sqrtf(wave_sum(sa) * (1.f / D) + EPS), rb = 1.f / sqrtf(wave_sum(sb) * (1.f / D) + EPS);
        f32x4* oa = (f32x4*)(a.out() + (size_t)row * D) + lane; f32x4* ob = (f32x4*)(a.out() + (size_t)(row + stride) * D) + lane;
#pragma unroll
        for (int j = 0; j < 4; ++j) { oa[64 * j] = va[j] * ra * g[j]; if (hasB) ob[64 * j] = vb[j] * rb * g[j]; }
        if (!hasN) break;
#pragma unroll
        for (int j = 0; j < 4; ++j) { va[j] = na[j]; vb[j] = nb[j]; }
        row = nrow; hasB = hasNB;
    }
}

__device__ __forceinline__ void lds_barrier() { asm volatile("s_waitcnt lgkmcnt(0)" ::: "memory"); __builtin_amdgcn_s_barrier(); asm volatile("" ::: "memory"); }
constexpr int TS = 272;
struct TrRegs { u32x4 x[2][2]; };
struct RmRegs { u32x4 x[4]; };
__device__ __forceinline__ void load_tr(TrRegs& r, const bf16_t* src, int ld, int tid) {
#pragma unroll
    for (int i = 0; i < 2; ++i) { const int p = tid + 512 * i, jp = p & 63, o = p >> 6;
        const unsigned off = (unsigned)((2 * jp) * ld + o * 8);
        r.x[i][0] = *(const u32x4*)(src + off); r.x[i][1] = *(const u32x4*)(src + off + (unsigned)ld); }
}
__device__ __forceinline__ void store_tr(LAS unsigned char* dst, const TrRegs& r, int tid, bool weighted, float A, float Bc) {
#pragma unroll
    for (int i = 0; i < 2; ++i) {
        const int p = tid + 512 * i, jp = p & 63, o = p >> 6;
        const u32x4 x0 = r.x[i][0], x1 = r.x[i][1];
        const float w0 = weighted ? __builtin_amdgcn_exp2f(A + Bc * (float)(2 * jp)) : 1.f, w1 = weighted ? __builtin_amdgcn_exp2f(A + Bc * (float)(2 * jp + 1)) : 1.f;
#pragma unroll
        for (int c = 0; c < 8; ++c) {
            const unsigned a0 = x0[c >> 1], a1 = x1[c >> 1];
            const float e0 = (c & 1) ? bf_hi(a0) : bf_lo(a0), e1 = (c & 1) ? bf_hi(a1) : bf_lo(a1);
            *(LAS unsigned*)(dst + (8 * o + c) * TS + 4 * jp) = cvt_pk(e0 * w0, e1 * w1);
        }
    }
}
__device__ __forceinline__ void load_rm(RmRegs& r, const bf16_t* src, int ld, int tid) {
#pragma unroll
    for (int i = 0; i < 4; ++i) { const int p = tid + 512 * i, row = p >> 4, seg = p & 15; r.x[i] = *(const u32x4*)(src + (unsigned)(row * ld + seg * 8)); }
}
__device__ __forceinline__ void store_rm(LAS unsigned char* dst, const RmRegs& r, int tid) {
#pragma unroll
    for (int i = 0; i < 4; ++i) { const int p = tid + 512 * i, row = p >> 4, seg = p & 15; *(LAS u32x4*)(dst + row * TS + seg * 16) = r.x[i]; }
}
__device__ __forceinline__ bf16x8 frag(const LAS unsigned char* buf, int row, int ks, int fq) { return *(const LAS bf16x8*)(buf + row * TS + (32 * ks + 8 * fq) * 2); }

__device__ __forceinline__ void chunk_rows(int b, int vf, int& rows0, int& vb) {
    if (vf < 2) { rows0 = ML + b * CTXL + vf * 128; vb = 16 + vf; } else { rows0 = b * SEQ + (vf - 2) * 128; vb = vf - 2; }
}

__device__ __forceinline__ void kv_prefetch(const KA& a, TrRegs& rk, TrRegs& rv, int it, int tid) {
    const int b = it / 72, h = (it / 18) & 3, vf = it % 18; int rows0, vb; chunk_rows(b, vf, rows0, vb);
    const bf16_t* PB = (const bf16_t*)(a.ws() + WS_HID);
    load_tr(rk, PB + (size_t)rows0 * PBW + 768 + h * 128, PBW, tid); load_tr(rv, PB + (size_t)rows0 * PBW + 1280 + h * 128, PBW, tid);
}
__device__ __forceinline__ void kv_loop(const KA& a, int l, LAS unsigned char* lds, int tid, int lane, int wid, int bid, int G) {
    int it = bid; if (it >= 1152) return;
    TrRegs rk, rv; kv_prefetch(a, rk, rv, it, tid);
    LAS unsigned char* B0 = lds; LAS unsigned char* B1 = lds + 34816; LAS unsigned char* B2 = lds + 69632;
    const int fr = lane & 15, fq = lane >> 4;
    for (; it < 1152; it += G) {
        const int b = it / 72, h = (it / 18) & 3, vf = it % 18; int rows0, vb; chunk_rows(b, vf, rows0, vb);
        const float lf = log2gamma(a, 0, l, h), lb = log2gamma(a, 1, l, h);
        store_tr(B0, rk, tid, false, 0.f, 0.f); store_tr(B1, rv, tid, true, 127.f * lf, -lf); store_tr(B2, rv, tid, true, 0.f, lb);
        lds_barrier();
        kv_prefetch(a, rk, rv, (it + G < 1152) ? it + G : it, tid);
        bf16x8 af[4];
#pragma unroll
        for (int ks = 0; ks < 4; ++ks) af[ks] = frag(B0, 16 * wid + fr, ks, fq);
        bf16_t* KVF = (bf16_t*)(a.ws() + WS_KV) + ((size_t)(b * 4 + h) * 18 + vf) * 16384;
        bf16_t* KVB = (bf16_t*)(a.ws() + WS_KV) + (size_t)1152 * 16384 + ((size_t)(b * 4 + h) * 18 + vb) * 16384;
#pragma unroll
        for (int nb0 = 0; nb0 < 8; nb0 += 2) {
            bf16x8 f1[2][4], f2[2][4];
#pragma unroll
            for (int j = 0; j < 2; ++j)
#pragma unroll
                for (int ks = 0; ks < 4; ++ks) { f1[j][ks] = frag(B1, 16 * (nb0 + j) + fr, ks, fq); f2[j][ks] = frag(B2, 16 * (nb0 + j) + fr, ks, fq); }
            f32x4 cf[2], cb[2];
#pragma unroll
            for (int j = 0; j < 2; ++j) { cf[j] = (f32x4){0.f, 0.f, 0.f, 0.f}; cb[j] = (f32x4){0.f, 0.f, 0.f, 0.f}; }
            __builtin_amdgcn_s_setprio(1);
#pragma unroll
            for (int ks = 0; ks < 4; ++ks)
#pragma unroll
                for (int j = 0; j < 2; ++j) {
                    cf[j] = __builtin_amdgcn_mfma_f32_16x16x32_bf16(af[ks], f1[j][ks], cf[j], 0, 0, 0);
                    cb[j] = __builtin_amdgcn_mfma_f32_16x16x32_bf16(af[ks], f2[j][ks], cb[j], 0, 0, 0);
                }
            __builtin_amdgcn_s_setprio(0);
#pragma unroll
            for (int j = 0; j < 2; ++j) {
                const int off = (16 * (nb0 + j) + fr) * 128 + 16 * wid + 4 * fq;
                u32x2 w; w.x = cvt_pk(cf[j][0], cf[j][1]); w.y = cvt_pk(cf[j][2], cf[j][3]); *(u32x2*)(KVF + off) = w;
                w.x = cvt_pk(cb[j][0], cb[j][1]); w.y = cvt_pk(cb[j][2], cb[j][3]); *(u32x2*)(KVB + off) = w;
            }
        }
        lds_barrier();
    }
}

__device__ __forceinline__ void seq_tile(int idx, int& rowbase, int& L, int& t0) {
    if (idx < 512) { rowbase = (idx >> 5) * SEQ; L = SEQ; t0 = (idx & 31) * 64; } else { const int e = idx - 512; rowbase = ML + (e >> 2) * CTXL; L = CTXL; t0 = (e & 3) * 64; }
}

__device__ __forceinline__ void pool_tile_load(const KA& a, int idx, int tid, u32x4 (&pv)[5]) {
    int rowbase, L, t0; seq_tile(idx, rowbase, L, t0);
    const bf16_t* PB = (const bf16_t*)(a.ws() + WS_HID);
    unsigned zz = 0u; asm volatile("" : "+v"(zz));
#pragma unroll
    for (int k = 0; k < 5; ++k) { const int i = tid + 512 * k, rr = i >> 5, seg = i & 31, t = t0 - 8 + rr;
        pv[k] = (u32x4){zz, zz, zz, zz}; if (t >= 0 && t < L) pv[k] = *(const u32x4*)(PB + (size_t)(rowbase + t) * PBW + seg * 8); }
}
__device__ __forceinline__ void pool_loop(const KA& a, int l, int it0, int np, LAS unsigned char* lds, int tid, int lane, int wid, int G) {
    int idx = it0; if (idx >= np) return;
    bf16_t* CAT = (bf16_t*)(a.ws() + WS_H);
    LAS float* PT = (LAS float*)lds;
    LAS bf16_t* PL = (LAS bf16_t*)(lds + 81920);
    const int g = wid >> 1, thw = wid & 1, fr = lane & 15, fq = lane >> 4;
    bf16x8 wf[4][2]; f32x4 scv[4];
    { const bf16_t* pwt = (const bf16_t*)(a.ws() + WS_PWT) + (size_t)(l * 4 + g) * 4096; const float* psc = a.in(13) + l * 256 + g * 64;
#pragma unroll
      for (int mb = 0; mb < 4; ++mb) {
#pragma unroll
          for (int ks = 0; ks < 2; ++ks) wf[mb][ks] = *(const bf16x8*)(pwt + (16 * mb + fr) * 64 + 32 * ks + 8 * fq);
          scv[mb] = *(const f32x4*)(psc + 16 * mb + 4 * fq);
      } }
    u32x4 pv[5]; pool_tile_load(a, idx, tid, pv);
    for (;;) {
        int rowbase, L, t0; seq_tile(idx, rowbase, L, t0);
#pragma unroll
        for (int k = 0; k < 5; ++k) { const int i = tid + 512 * k, rr = i >> 5, seg = i & 31; const u32x4 v = pv[k];
            LAS f32x4* d = (LAS f32x4*)(PT + rr * 256 + seg * 8);
            d[0] = (f32x4){bf_lo(v.x), bf_hi(v.x), bf_lo(v.y), bf_hi(v.y)}; d[1] = (f32x4){bf_lo(v.z), bf_hi(v.z), bf_lo(v.w), bf_hi(v.w)}; }
        lds_barrier();
        const int nidx = idx + G; const bool hasN = nidx < np;
        if (hasN) pool_tile_load(a, nidx, tid, pv);
        {
            const int ch = tid & 255, th = tid >> 8, hw = 1 << (ch >> 6);
            const LAS float* col = PT + ch;
            const int tl0 = th * 32;
            float sw = 0.f;
            for (int uu = tl0 - hw; uu < tl0 + hw; ++uu) sw += col[(uu + 8) * 256];
#pragma unroll 8
            for (int tt = 0; tt < 32; ++tt) {
                const int tl = tl0 + tt, t = t0 + tl;
                const int lo = max(t - hw, 0), hi = min(t + hw, L);
                const float self = col[(tl + 8) * 256];
                const float val = sw * __builtin_amdgcn_rcpf((float)(hi - lo)) - self;
                PL[tl * 264 + ch] = (bf16_t)(cvt_pk(val, 0.f) & 0xffffu);
                sw += col[(tl + 8 + hw) * 256] - col[(tl + 8 - hw) * 256];
            }
        }
        lds_barrier();
#pragma unroll
        for (int tb = 0; tb < 2; ++tb) {
            const int tl = 32 * thw + 16 * tb + fr;
            bf16x8 bfr[2];
#pragma unroll
            for (int ks = 0; ks < 2; ++ks) bfr[ks] = *(const LAS bf16x8*)((const LAS unsigned char*)PL + tl * 528 + (g * 64 + 32 * ks + 8 * fq) * 2);
#pragma unroll
            for (int mb = 0; mb < 4; ++mb) {
                f32x4 c = (f32x4){0.f, 0.f, 0.f, 0.f};
#pragma unroll
                for (int ks = 0; ks < 2; ++ks) c = __builtin_amdgcn_mfma_f32_16x16x32_bf16(wf[mb][ks], bfr[ks], c, 0, 0, 0);
                c = c * scv[mb];
                u32x2 w; w.x = cvt_pk(c[0], c[1]); w.y = cvt_pk(c[2], c[3]);
                *(u32x2*)(CAT + (size_t)(rowbase + t0 + tl) * D + g * 64 + 16 * mb + 4 * fq) = w;
            }
        }
        lds_barrier();
        if (!hasN) break;
        idx = nidx;
    }
}

__device__ __forceinline__ void conv_tile_load(const KA& a, int idx, int tid, u32x4 (&cv)[6]) {
    int rowbase, L, t0; seq_tile(idx, rowbase, L, t0);
    const bf16_t* PB = (const bf16_t*)(a.ws() + WS_HID);
    unsigned zz = 0u; asm volatile("" : "+v"(zz));
#pragma unroll
    for (int k = 0; k < 6; ++k) { const int i = tid + 512 * k, rr = i >> 5, seg = i & 31, t = t0 - 15 + rr;
        cv[k] = (u32x4){zz, zz, zz, zz}; if (i < 94 * 32 && t >= 0 && t < L) cv[k] = *(const u32x4*)(PB + (size_t)(rowbase + t) * PBW + 2304 + seg * 8); }
}
__device__ __forceinline__ void conv_loop(const KA& a, int l, int it0, int np, LAS unsigned char* lds, int tid, int lane, int wid, int G) {
    int idx = it0; if (idx >= np) return;
    bf16_t* CAT = (bf16_t*)(a.ws() + WS_H);
    LAS bf16_t* ZT = (LAS bf16_t*)lds;
    LAS float* CO = (LAS float*)(lds + 48128);
    float wk[31]; float bias;
    { const int c = tid & 255; const float* dw = a.in(17) + (size_t)l * 31 * 256 + c;
#pragma unroll
      for (int k = 0; k < 31; ++k) wk[k] = dw[k * 256];
      bias = a.in(18)[l * 256 + c]; }
    const f32x4 lg = *(const f32x4*)(a.in(19) + l * 256 + 4 * lane), lbv = *(const f32x4*)(a.in(20) + l * 256 + 4 * lane);
    u32x4 cv[6]; conv_tile_load(a, idx, tid, cv);
    for (;;) {
        int rowbase, L, t0; seq_tile(idx, rowbase, L, t0);
#pragma unroll
        for (int k = 0; k < 6; ++k) { const int i = tid + 512 * k, rr = i >> 5, seg = i & 31; if (i < 94 * 32) *(LAS u32x4*)(lds + rr * 512 + seg * 16) = cv[k]; }
        lds_barrier();
        const int nidx = idx + G; const bool hasN = nidx < np;
        if (hasN) conv_tile_load(a, nidx, tid, cv);
        {
            const int c = tid & 255, th = tid >> 8;
            float zr[62];
#pragma unroll
            for (int uu = 0; uu < 62; ++uu) zr[uu] = __uint_as_float((unsigned)ZT[(32 * th + uu) * 256 + c] << 16);
            float acc[32];
#pragma unroll
            for (int t = 0; t < 32; ++t) acc[t] = bias;
#pragma unroll
            for (int k = 0; k < 31; ++k) {
#pragma unroll
                for (int t = 0; t < 32; ++t) acc[t] += zr[t + k] * wk[k];
            }
#pragma unroll
            for (int t = 0; t < 32; ++t) CO[(32 * th + t) * 260 + c] = acc[t];
        }
        lds_barrier();
#pragma unroll
        for (int tt = 0; tt < 8; ++tt) {
            const int tl = 8 * wid + tt;
            const f32x4 v = *(const LAS f32x4*)(CO + tl * 260 + 4 * lane);
            const float mu = wave_sum((v.x + v.y) + (v.z + v.w)) * (1.f / 256.f);
            const f32x4 dv = v - mu;
            const float var = wave_sum((dv.x * dv.x + dv.y * dv.y) + (dv.z * dv.z + dv.w * dv.w)) * (1.f / 256.f);
            const float rstd = 1.f / sqrtf(var + EPS);
            const f32x4 y = dv * rstd * lg + lbv;
            u32x2 w; w.x = cvt_pk(silu_f(y.x), silu_f(y.y)); w.y = cvt_pk(silu_f(y.z), silu_f(y.w));
            *(u32x2*)(CAT + (size_t)(rowbase + t0 + tl) * D + 768 + 4 * lane) = w;
        }
        lds_barrier();
        if (!hasN) break;
        idx = nidx;
    }
}

__device__ __forceinline__ bf16_t* scan_base(const KA& a, int u) {
    const int dir = u >> 17, bh = (u >> 11) & 63, e8 = u & 2047;
    return (bf16_t*)(a.ws() + WS_KV) + (size_t)dir * 1152 * 16384 + (size_t)bh * 18 * 16384 + e8 * 8;
}
__device__ __forceinline__ void scan_phase(const KA& a, int l, int tid, int bid, int G) {
    const int step = G * 512;
    int u = bid * 512 + tid; if (u >= 262144) return;
    u32x4 t[18];
    { const bf16_t* b0 = scan_base(a, u);
#pragma unroll
      for (int nn = 0; nn < 18; ++nn) t[nn] = *(const u32x4*)(b0 + (size_t)nn * 16384); }
    for (;;) {
        const int nu = u + step; const bool hasN = nu < 262144;
        u32x4 tn[18];
        if (hasN) { const bf16_t* bn = scan_base(a, nu);
#pragma unroll
            for (int nn = 0; nn < 18; ++nn) tn[nn] = *(const u32x4*)(bn + (size_t)nn * 16384); }
        const int dir = u >> 17, h = (u >> 11) & 3;
        bf16_t* base = scan_base(a, u);
        const float dec = __builtin_amdgcn_exp2f(128.f * log2gamma(a, dir, l, h));
        float S[8]; float zf = 0.f; asm volatile("" : "+v"(zf));
#pragma unroll
        for (int i = 0; i < 8; ++i) S[i] = zf;
        if (dir == 0) {
#pragma unroll
            for (int n = 0; n < 18; ++n) {
                const u32x4 v = t[n];
                u32x4 o; o.x = cvt_pk(S[0], S[1]); o.y = cvt_pk(S[2], S[3]); o.z = cvt_pk(S[4], S[5]); o.w = cvt_pk(S[6], S[7]);
                *(u32x4*)(base + (size_t)n * 16384) = o;
                S[0] = S[0] * dec + bf_lo(v.x); S[1] = S[1] * dec + bf_hi(v.x); S[2] = S[2] * dec + bf_lo(v.y); S[3] = S[3] * dec + bf_hi(v.y);
                S[4] = S[4] * dec + bf_lo(v.z); S[5] = S[5] * dec + bf_hi(v.z); S[6] = S[6] * dec + bf_lo(v.w); S[7] = S[7] * dec + bf_hi(v.w);
            }
        } else {
#pragma unroll
            for (int n = 17; n >= 0; --n) {
                const u32x4 v = t[n];
                u32x4 o; o.x = cvt_pk(S[0], S[1]); o.y = cvt_pk(S[2], S[3]); o.z = cvt_pk(S[4], S[5]); o.w = cvt_pk(S[6], S[7]);
                *(u32x4*)(base + (size_t)n * 16384) = o;
                S[0] = S[0] * dec + bf_lo(v.x); S[1] = S[1] * dec + bf_hi(v.x); S[2] = S[2] * dec + bf_lo(v.y); S[3] = S[3] * dec + bf_hi(v.y);
                S[4] = S[4] * dec + bf_lo(v.z); S[5] = S[5] * dec + bf_hi(v.z); S[6] = S[6] * dec + bf_lo(v.w); S[7] = S[7] * dec + bf_hi(v.w);
            }
        }
        if (!hasN) break;
#pragma unroll
        for (int nn = 0; nn < 18; ++nn) t[nn] = tn[nn];
        u = nu;
    }
}

struct RetPre { RmRegs rk; TrRegs rv; };
__device__ __forceinline__ void ret_decode(int it, int& b, int& h, int& vf) {
    if (it < 1024) { b = it >> 6; h = (it >> 4) & 3; vf = 2 + (it & 15); } else { const int e = it - 1024; b = e >> 3; h = (e >> 1) & 3; vf = e & 1; }
}
__device__ __forceinline__ void ret_prefetch(const KA& a, RetPre& R, int it, int tid, int iloc, int fq) {
    int b, h, vf; ret_decode(it, b, h, vf); int rows0, vb; chunk_rows(b, vf, rows0, vb);
    const bf16_t* PB = (const bf16_t*)(a.ws() + WS_HID);
    load_rm(R.rk, PB + (size_t)rows0 * PBW + 768 + h * 128, PBW, tid); load_tr(R.rv, PB + (size_t)rows0 * PBW + 1280 + h * 128, PBW, tid);
}
__device__ __forceinline__ void ret_prefetch_sf(const KA& a, RmRegs& rsf, bf16x8 (&qn)[4], int it, int tid, int iloc, int fq) {
    int b, h, vf; ret_decode(it, b, h, vf); int rows0, vb; chunk_rows(b, vf, rows0, vb);
    load_rm(rsf, (const bf16_t*)(a.ws() + WS_KV) + ((size_t)(b * 4 + h) * 18 + vf) * 16384, 128, tid);
    const bf16_t* Qs = (const bf16_t*)(a.ws() + WS_HID) + (size_t)rows0 * PBW + 256 + h * 128;
#pragma unroll
    for (int ks = 0; ks < 4; ++ks) qn[ks] = *(const bf16x8*)(Qs + (unsigned)(iloc * PBW + 32 * ks + 8 * fq));
}
__device__ __forceinline__ void retout_loop(const KA& a, int l, int nit, LAS unsigned char* lds, int tid, int lane, int wid, int bid, int G) {
    int it = bid; if (it >= nit) return;
    const int fr = lane & 15, fq = lane >> 4, iloc_ = 16 * wid + fr;
    RetPre R; ret_prefetch(a, R, it, tid, iloc_, fq);
    RmRegs rsf; bf16x8 qn[4]; ret_prefetch_sf(a, rsf, qn, it, tid, iloc_, fq);
    LAS unsigned char* B0 = lds; LAS unsigned char* B1 = lds + 34816; LAS unsigned char* B2 = lds + 69632; LAS unsigned char* PBUF = lds + 104448;
    for (; it < nit; it += G) {
        int b, h, vf; ret_decode(it, b, h, vf); int rows0, vb; chunk_rows(b, vf, rows0, vb);
        int iloc = iloc_; asm volatile("" : "+v"(iloc));
        const bf16_t* PB = (const bf16_t*)(a.ws() + WS_HID); bf16_t* CAT = (bf16_t*)(a.ws() + WS_H);
        const bf16_t* Gs = PB + (size_t)rows0 * PBW + 1792 + h * 128;
        const bf16_t* SB = (const bf16_t*)(a.ws() + WS_KV) + (size_t)1152 * 16384 + ((size_t)(b * 4 + h) * 18 + vb) * 16384;
        const float lf = log2gamma(a, 0, l, h), lb = log2gamma(a, 1, l, h);
        bf16x8 qa[4];
#pragma unroll
        for (int ks = 0; ks < 4; ++ks) qa[ks] = qn[ks];
        store_rm(B0, R.rk, tid); store_tr(B1, R.rv, tid, false, 0.f, 0.f); store_rm(B2, rsf, tid);
        lds_barrier();
        RmRegs rsb; load_rm(rsb, SB, 128, tid);
        ret_prefetch(a, R, (it + G < nit) ? it + G : it, tid, iloc, fq);
#pragma unroll
        for (int nb0 = 0; nb0 < 8; nb0 += 4) {
            bf16x8 kf[4][4];
#pragma unroll
            for (int j = 0; j < 4; ++j)
#pragma unroll
                for (int ks = 0; ks < 4; ++ks) kf[j][ks] = frag(B0, 16 * (nb0 + j) + fr, ks, fq);
            f32x4 c[4];
#pragma unroll
            for (int j = 0; j < 4; ++j) c[j] = (f32x4){0.f, 0.f, 0.f, 0.f};
#pragma unroll
            for (int ks = 0; ks < 4; ++ks)
#pragma unroll
                for (int j = 0; j < 4; ++j) c[j] = __builtin_amdgcn_mfma_f32_16x16x32_bf16(kf[j][ks], qa[ks], c[j], 0, 0, 0);
#pragma unroll
            for (int j = 0; j < 4; ++j) {
                const int nb = nb0 + j; float p[4];
#pragma unroll
                for (int r = 0; r < 4; ++r) { const int df = iloc - (16 * nb + 4 * fq + r); p[r] = c[j][r] * (df >= 0 ? __builtin_amdgcn_exp2f((float)df * lf) : __builtin_amdgcn_exp2f((float)(-df) * lb)); }
                u32x2 w; w.x = cvt_pk(p[0], p[1]); w.y = cvt_pk(p[2], p[3]);
                *(LAS u32x2*)(PBUF + iloc * TS + (16 * nb + 4 * fq) * 2) = w;
            }
        }
        f32x4 O[8];
        const float wf = __builtin_amdgcn_exp2f((float)(iloc + 1) * lf), wb = __builtin_amdgcn_exp2f((float)(128 - iloc) * lb);
#pragma unroll
        for (int nb0 = 0; nb0 < 8; nb0 += 4) {
            bf16x8 sf[4][4];
#pragma unroll
            for (int j = 0; j < 4; ++j)
#pragma unroll
                for (int ks = 0; ks < 4; ++ks) sf[j][ks] = frag(B2, 16 * (nb0 + j) + fr, ks, fq);
            f32x4 c[4];
#pragma unroll
            for (int j = 0; j < 4; ++j) c[j] = (f32x4){0.f, 0.f, 0.f, 0.f};
#pragma unroll
            for (int ks = 0; ks < 4; ++ks)
#pragma unroll
                for (int j = 0; j < 4; ++j) c[j] = __builtin_amdgcn_mfma_f32_16x16x32_bf16(sf[j][ks], qa[ks], c[j], 0, 0, 0);
#pragma unroll
            for (int j = 0; j < 4; ++j) O[nb0 + j] = c[j] * wf;
        }
        lds_barrier();
        store_rm(B0, rsb, tid);
        {
            bf16x8 pf[4];
#pragma unroll
            for (int ks = 0; ks < 4; ++ks) pf[ks] = frag(PBUF, iloc, ks, fq);
#pragma unroll
            for (int nb0 = 0; nb0 < 8; nb0 += 4) {
                bf16x8 vf4[4][4];
#pragma unroll
                for (int j = 0; j < 4; ++j)
#pragma unroll
                    for (int ks = 0; ks < 4; ++ks) vf4[j][ks] = frag(B1, 16 * (nb0 + j) + fr, ks, fq);
#pragma unroll
                for (int ks = 0; ks < 4; ++ks)
#pragma unroll
                    for (int j = 0; j < 4; ++j) O[nb0 + j] = __builtin_amdgcn_mfma_f32_16x16x32_bf16(vf4[j][ks], pf[ks], O[nb0 + j], 0, 0, 0);
            }
        }
        lds_barrier();
        u32x2 gv[8];
#pragma unroll
        for (int nb = 0; nb < 8; ++nb) gv[nb] = *(const u32x2*)(Gs + (unsigned)(iloc * PBW + 16 * nb + 4 * fq));
        f32x4 ggv[8];
        { const float* gnp = a.in(16) + l * 512 + h * 128 + 4 * fq;
#pragma unroll
          for (int nb = 0; nb < 8; ++nb) ggv[nb] = *(const f32x4*)(gnp + 16 * nb); }
        ret_prefetch_sf(a, rsf, qn, (it + G < nit) ? it + G : it, tid, iloc, fq);
#pragma unroll
        for (int nb0 = 0; nb0 < 8; nb0 += 4) {
            bf16x8 bfm[4][4];
#pragma unroll
            for (int j = 0; j < 4; ++j)
#pragma unroll
                for (int ks = 0; ks < 4; ++ks) bfm[j][ks] = frag(B0, 16 * (nb0 + j) + fr, ks, fq);
            f32x4 c[4];
#pragma unroll
            for (int j = 0; j < 4; ++j) c[j] = (f32x4){0.f, 0.f, 0.f, 0.f};
#pragma unroll
            for (int ks = 0; ks < 4; ++ks)
#pragma unroll
                for (int j = 0; j < 4; ++j) c[j] = __builtin_amdgcn_mfma_f32_16x16x32_bf16(bfm[j][ks], qa[ks], c[j], 0, 0, 0);
#pragma unroll
            for (int j = 0; j < 4; ++j) O[nb0 + j] += c[j] * wb;
        }
        float s = 0.f;
#pragma unroll
        for (int nb = 0; nb < 8; ++nb) s += (O[nb][0] + O[nb][1]) + (O[nb][2] + O[nb][3]);
        s += __shfl_xor(s, 16); s += __shfl_xor(s, 32);
        const float mu = s * (1.f / 128.f);
        float q = 0.f;
#pragma unroll
        for (int nb = 0; nb < 8; ++nb) { const f32x4 d = O[nb] - mu; q += (d[0] * d[0] + d[1] * d[1]) + (d[2] * d[2] + d[3] * d[3]); }
        q += __shfl_xor(q, 16); q += __shfl_xor(q, 32);
        const float rstd = 1.f / sqrtf(q * (1.f / 128.f) + EPS);
#pragma unroll
        for (int nb = 0; nb < 8; ++nb) {
            const int e0 = 16 * nb + 4 * fq;
            const f32x4 y = (O[nb] - mu) * rstd * ggv[nb];
            u32x2 w; w.x = cvt_pk(y[0] * silu_f(bf_lo(gv[nb].x)), y[1] * silu_f(bf_hi(gv[nb].x))); w.y = cvt_pk(y[2] * silu_f(bf_lo(gv[nb].y)), y[3] * silu_f(bf_hi(gv[nb].y)));
            *(u32x2*)(CAT + (size_t)(rows0 + iloc) * D + 256 + h * 128 + e0) = w;
        }
        lds_barrier();
    }
}

#define XB_TMO      128
#define XB_XCNT(j)  (256  + 64 * (j))
#define XB_XSUB(j)  (1280 + 64 * (j))
#define XB_XGEN(j)  (2304 + 64 * (j))
#define XB_TOP      3328
#define XB_TOPGEN   3392
#define XCD_BAR_WORDS 3456
#define XB_SPIN_CAP (1u << 18)

__device__ __forceinline__ unsigned xb_ld(unsigned* p)              { return __hip_atomic_load(p, __ATOMIC_RELAXED, __HIP_MEMORY_SCOPE_AGENT); }
__device__ __forceinline__ unsigned xb_add(unsigned* p, unsigned v) { return __hip_atomic_fetch_add(p, v, __ATOMIC_RELAXED, __HIP_MEMORY_SCOPE_AGENT); }
__device__ __forceinline__ unsigned xb_xcc_id() { return (unsigned)__builtin_amdgcn_s_getreg((3 << 11) | 20) & 0xFu; }
#define XB_SPIN(cond, bar) do { unsigned _sp = 0; while (cond) { __builtin_amdgcn_s_sleep(1); \
    if ((++_sp & 255u) == 0u) { if (xb_ld(&(bar)[XB_TMO])) break; if (_sp > XB_SPIN_CAP) { atomicAdd(&(bar)[XB_TMO], 1u); break; } } } } while (0)

struct XcdBarrier {
    unsigned* bar; unsigned x;
    volatile LAS unsigned* st;
};

__device__ __forceinline__ XcdBarrier xcd_barrier_post(unsigned* bar, volatile LAS unsigned* st) {
    XcdBarrier b; b.bar = bar; b.x = xb_xcc_id(); b.st = st;
    if (threadIdx.x == 0) (void)xb_add(&bar[XB_XCNT(b.x)], 1u);
    return b;
}
__device__ __forceinline__ void xcd_barrier_complete(unsigned* bar, unsigned x, unsigned& nloc, unsigned& nx) {
    const unsigned G = gridDim.x * gridDim.y * gridDim.z;
    unsigned sum, cnt, mine, sp = 0u;
    for (;;) {
        sum = 0u; cnt = 0u; mine = 0u;
#pragma unroll
        for (unsigned j = 0; j < 16; ++j) { const unsigned c = xb_ld(&bar[XB_XCNT(j)]); sum += c; cnt += (c > 0u) ? 1u : 0u; mine = (j == x) ? c : mine; }
        if (sum == G) break;
        __builtin_amdgcn_s_sleep(1);
        if ((++sp & 255u) == 0u) { if (xb_ld(&bar[XB_TMO])) break; if (sp > XB_SPIN_CAP) { atomicAdd(&bar[XB_TMO], 1u); break; } }
    }
    nloc = mine > 0u ? mine : 1u; nx = cnt > 0u ? cnt : 1u;
}

__device__ __forceinline__ void xcd_barrier(const XcdBarrier& b) {
    asm volatile("s_waitcnt vmcnt(0)" ::: "memory");
    __syncthreads();
    if (threadIdx.x == 0) {
        unsigned* bar = b.bar;
        __builtin_amdgcn_s_waitcnt(0);
        unsigned nloc = b.st[0], nx = b.st[1];
        if (nloc == 0u) { xcd_barrier_complete(bar, b.x, nloc, nx); b.st[0] = nloc; b.st[1] = nx; }
        const unsigned old = xb_add(&bar[XB_XSUB(b.x)], 1u);
        const unsigned gen = old / nloc;
        if (old + 1u == (gen + 1u) * nloc) {
            __builtin_amdgcn_fence(__ATOMIC_RELEASE, "agent");
            asm volatile("s_waitcnt vmcnt(0)" ::: "memory");
            const unsigned og = xb_add(&bar[XB_TOP], 1u);
            const unsigned tg = og / nx;
            if (og + 1u == (tg + 1u) * nx) xb_add(&bar[XB_TOPGEN], 1u);
            else XB_SPIN(xb_ld(&bar[XB_TOPGEN]) == tg, bar);
            __builtin_amdgcn_fence(__ATOMIC_ACQUIRE, "agent");
            xb_add(&bar[XB_XGEN(b.x)], 1u);
            asm volatile("s_waitcnt vmcnt(0)" ::: "memory");
        } else {
            XB_SPIN(xb_ld(&bar[XB_XGEN(b.x)]) == gen, bar);
            __builtin_amdgcn_fence(__ATOMIC_ACQUIRE, "agent");
            asm volatile("s_waitcnt vmcnt(0)" ::: "memory");
        }
    }
    __syncthreads();
}


__global__ void __launch_bounds__(512, 2) fwd_kernel(Args a_) {
    extern __shared__ __attribute__((aligned(16))) unsigned char lds_raw[];
    LAS unsigned char* lds = (LAS unsigned char*)lds_raw;
    const int G = gridDim.x, bid = blockIdx.x;
    volatile LAS unsigned* bst = (volatile LAS unsigned*)(lds + LDS_BYTES - 64);
    if (threadIdx.x < 2) bst[threadIdx.x] = 0u;
    __syncthreads();
    if (a_.ph_hi - a_.ph_lo > 1) (void)xcd_barrier_post((unsigned*)(a_.ws + WS_BAR), bst);

    for (int ph = a_.ph_lo; ph < a_.ph_hi; ++ph) {
        int tid_ = threadIdx.x; asm volatile("" : "+v"(tid_));
        const int tid = tid_, lane = tid & 63, wid = __builtin_amdgcn_readfirstlane(tid >> 6);
        int kz; asm volatile("s_mov_b32 %0, 0" : "=s"(kz));
        KA a; a.kb = (const char*)__builtin_amdgcn_kernarg_segment_ptr() + kz;
        float* XC = (float*)(a.ws() + WS_XC);
        bf16_t* Hb = (bf16_t*)(a.ws() + WS_H);
        bf16_t* HID = (bf16_t*)(a.ws() + WS_HID);
        const float* MXb = (const float*)(a.ws() + WS_MX);
        if (ph == 0) prep_phase(a, lds, tid, bid, G);
        else if (ph == NPH - 1) final_phase(a, lane, wid, bid, G);
        else {
            const int l = (ph - 1) / 12, s = (ph - 1) % 12;
            const bool first = (l == 0), lastl = (l == 1);
            const bf16_t* WT = (const bf16_t*)(a.ws() + WS_WT) + (size_t)l * WT_LAYER;
            if (s == 0 || s == 3 || s == 9) {
                const int sub = s == 0 ? 0 : (s == 3 ? 1 : 2);
                const bool in0 = first && s == 0;
                const int nrows = (lastl && s == 9) ? ML : MT;
                norm_phase(a, l, sub, nrows, in0 ? a.in(0) : a.out(), in0 ? a.in(2) : XC, !in0, lane, wid, bid, G);
            } else if (s == 1 || s == 10) {
                Gemm g{Hb, WT + (s == 1 ? WT_G1A : WT_G1B), D};
                Order S; S.init(((lastl && s == 10) ? ML : MT) / BM, (2 * DFF) / BM, D, G, bid);
                EpiSwiglu E{HID};
                gemm_phase<EpiSwiglu, true>(lds, g, S, E);
            } else if (s == 2 || s == 8 || s == 11) {
                const bool in0 = first && s == 2;
                Gemm g{s == 8 ? Hb : HID, WT + (s == 2 ? WT_G2A : (s == 8 ? WT_WOUT : WT_G2B)), s == 8 ? D : DFF};
                Order S; S.init(ML / BM, D / BM, s == 8 ? D : DFF, G, bid);
                if (!(lastl && s != 2)) { S.xn = 128; S.xm0 = 128; S.xmn = 16; S.xn0 = 0; S.xs = 2; }
                EpiResid E{in0 ? a.in(0) : a.out(), in0 ? a.in(2) : XC, a.out(), XC, (float*)(a.ws() + WS_XP), MXb + (size_t)l * 17 * 9216, (s == 2 ? 2 : (s == 8 ? 5 : 8)) * D, s == 8 ? 1.f : 0.5f};
                gemm_phase<EpiResid, true>(lds, g, S, E);
            } else if (s == 4) {
                Gemm g{Hb, WT + WT_WIN, D};
                Order S; S.init((lastl ? ML : MT) / BM, INW / BM, D, G, bid);
                if (lastl) { S.xn = 64; S.xm0 = 128; S.xmn = 16; S.xn0 = 3; }
                EpiWin E{HID, (const float*)(a.ws() + WS_ROPE), (const float*)(a.ws() + WS_ROPE) + 2048};
                gemm_phase<EpiWin, true>(lds, g, S, E);
            } else if (s == 5) {
                const int np = lastl ? 512 : 576;
                kv_loop(a, l, lds, tid, lane, wid, bid, G);
                {
                    const int it0 = (bid + G / 2) % G;
                    conv_loop(a, l, it0, np, lds, tid, lane, wid, G);
                    int it = it0; while (it < np) it += G;
                    pool_loop(a, l, it - np, np, lds, tid, lane, wid, G);
                }
            } else if (s == 6) {
                scan_phase(a, l, tid, bid, G);
            } else if (s == 7) {
                retout_loop(a, l, lastl ? 1024 : 1152, lds, tid, lane, wid, bid, G);
            }
        }
        if (ph + 1 < a_.ph_hi) { if (a_.ph_lo < 0) cg::this_grid().sync(); else { XcdBarrier xb; xb.bar = (unsigned*)(a.ws() + WS_BAR); xb.x = xb_xcc_id(); xb.st = bst; xcd_barrier(xb); } }
    }
}

extern "C" void kernel_launch(void* const* d_in, const int* in_sizes, int n_in, void* d_out, int out_size, void* d_ws, size_t ws_size, hipStream_t stream) {
    static int grid = 0;
    if (grid == 0) {
        if (n_in != 22 || out_size != ML * D || ws_size < WS_END) { fprintf(stderr, "kernel_launch: unexpected shapes (n_in %d out %d ws %zu need %zu)\n", n_in, out_size, ws_size, (size_t)WS_END); grid = -1; return; }
        int dev = 0, cus = 0, per_cu = 0;
        hipGetDevice(&dev);
        hipDeviceGetAttribute(&cus, hipDeviceAttributeMultiprocessorCount, dev);
        if (hipFuncSetAttribute((const void*)fwd_kernel, hipFuncAttributeMaxDynamicSharedMemorySize, LDS_BYTES) != hipSuccess) { fprintf(stderr, "kernel_launch: hipFuncSetAttribute failed\n"); grid = -1; return; }
        hipOccupancyMaxActiveBlocksPerMultiprocessor(&per_cu, (const void*)fwd_kernel, 512, LDS_BYTES);
        if (per_cu < 1) { fprintf(stderr, "kernel_launch: occupancy query says %d blocks per CU\n", per_cu); per_cu = 1; }
        (void)hipGetLastError();
        grid = cus * 1;
    }
    if (grid < 0) return;
    Args a{};
    for (int i = 0; i < 22; ++i) a.in[i] = (const float*)d_in[i];
    a.out = (float*)d_out; a.ws = (unsigned char*)d_ws;
#if ONE_LAUNCH
    a.ph_lo = 0; a.ph_hi = NPH;
    if (hipMemsetAsync((char*)d_ws + WS_BAR, 0, 16384, stream) != hipSuccess) { fprintf(stderr, "kernel_launch: memset of barrier words failed\n"); return; }
    void* args[] = {&a};
    hipError_t e = hipLaunchCooperativeKernel((const void*)fwd_kernel, dim3(grid), dim3(512), args, LDS_BYTES, stream);
    if (e != hipSuccess) fprintf(stderr, "cooperative launch failed: %s (grid %d)\n", hipGetErrorString(e), grid);
#else
    for (int ph = 0; ph < NPH; ++ph) {
        a.ph_lo = ph; a.ph_hi = ph + 1;
        hipLaunchKernelGGL(fwd_kernel, dim3(grid), dim3(512), LDS_BYTES, stream, a);
    }
#endif
}
```

```cpp
#include <hip/hip_runtime.h>
#include <hip/hip_cooperative_groups.h>
#include <cstdio>
#include <cstdint>
namespace cg = cooperative_groups;

#ifndef ONE_LAUNCH
#define ONE_LAUNCH 1
#endif

#define LAS __attribute__((address_space(3)))
typedef unsigned short bf16_t;
typedef short bf16x8 __attribute__((ext_vector_type(8)));
typedef float f32x4 __attribute__((ext_vector_type(4)));
typedef unsigned u32x4 __attribute__((ext_vector_type(4)));
typedef unsigned u32x2 __attribute__((ext_vector_type(2)));

constexpr int D = 1024, NB = 16, SEQ = 2048, CTXL = 256, DFF = 2816, INW = 2816;
constexpr int ML = NB * SEQ, MC = NB * CTXL, MT = ML + MC;
constexpr int PBW = 2560;
constexpr float EPS = 1e-6f;
constexpr int NPH = 26;
constexpr int LDS_BYTES = 147456;

constexpr size_t WS_MX = 4096;
constexpr size_t WS_ROPE = WS_MX + 1253376;
constexpr size_t WS_PWT = WS_ROPE + 16384;
constexpr size_t WS_BAR = WS_PWT + 65536;
constexpr size_t WS_DEC = WS_BAR + 16384;
constexpr size_t WS_WT = 2097152;
constexpr size_t WT_LAYER = 21233664;
constexpr size_t WT_G1A = 0, WT_G2A = 5767168, WT_WIN = 8650752, WT_WOUT = 11534336, WT_G1B = 12582912, WT_G2B = 18350080;
constexpr size_t WS_XC = WS_WT + 2 * WT_LAYER * 2;
constexpr size_t WS_H = WS_XC + (size_t)MC * D * 4;
constexpr size_t WS_HID = WS_H + (size_t)MT * D * 2;
constexpr size_t WS_KV = WS_HID + (size_t)MT * DFF * 2;
constexpr size_t WS_XP = WS_KV + (size_t)2 * 1152 * 16384 * 2;
constexpr size_t WS_END = WS_XP + (size_t)MC * D * 4;

struct Args { const float* in[22]; float* out; unsigned char* ws; int ph_lo, ph_hi; };
struct KA {
    const char* kb;
    __device__ __forceinline__ const float* in(int i) const { return *(const float* const*)(kb + 8 * i); }
    __device__ __forceinline__ float* out() const { return *(float* const*)(kb + 176); }
    __device__ __forceinline__ unsigned char* ws() const { return *(unsigned char* const*)(kb + 184); }
};

typedef float f32x2_t __attribute__((ext_vector_type(2)));
typedef __bf16 bf16x2_t __attribute__((ext_vector_type(2)));
__device__ __forceinline__ unsigned cvt_pk(float lo, float hi) { const f32x2_t v = {lo, hi}; const bf16x2_t b = __builtin_convertvector(v, bf16x2_t); return __builtin_bit_cast(unsigned, b); }
__device__ __forceinline__ float bf_lo(unsigned w) { return __uint_as_float(w << 16); }
__device__ __forceinline__ float bf_hi(unsigned w) { return __uint_as_float(w & 0xffff0000u); }
__device__ __forceinline__ float sigmoid_f(float x) { return __builtin_amdgcn_rcpf(1.f + __expf(-x)); }
__device__ __forceinline__ float silu_f(float x) { return x * sigmoid_f(x); }
__device__ __forceinline__ float wave_sum(float v) {
#pragma unroll
    for (int o = 1; o < 64; o <<= 1) v += __shfl_xor(v, o);
    return v;
}
__device__ __forceinline__ float log2gamma(const KA& a, int dir, int l, int h) { return ((const float*)(a.ws() + WS_DEC))[dir * 8 + l * 4 + h]; }

constexpr int BM = 256, BK = 64, HALF = 128, HTB = HALF * BK * 2, NXCD = 8, WGM = 4;
__device__ __forceinline__ int lds_byte(int r, int c) { const int st = (r >> 4) * 2 + (c >> 5), rr = r & 15, cc = c & 31, ob = rr * 64 + cc * 2; return st * 1024 + (ob ^ (((ob >> 9) & 1) << 5)); }
__device__ __forceinline__ void stage_rc(int b, int& R, int& C) { const int st = b / 1024, sb = b % 1024, swz = sb ^ (((sb >> 9) & 1) << 5); R = (st >> 1) * 16 + swz / 64; C = (st & 1) * 32 + (swz % 64) / 2; }
struct Unit { int pm, pn, kt0, nt, split; };
struct Gemm { const bf16_t* A; const bf16_t* Bt; int K; };
struct Order {
    int nM, nN, nwg, G, c, ntf, xn, xm0, xmn, xn0, xs;
    __device__ void init(int nM_, int nN_, int K_, int G_, int c_) { nM = nM_; nN = nN_; nwg = nM * nN; G = G_; c = c_; ntf = K_ / BK; xn = 0; xm0 = 0; xmn = 1; xn0 = 0; xs = 1; }
    __device__ bool next(int i, Unit& u) const {
        const long L = (long)i * G + c;
        if (L >= nwg) { const int e = (int)(L - nwg); if (e >= xn) return false; const int ue = e / xs, part = e % xs;
            u.pm = xm0 + ue % xmn; u.pn = xn0 + ue / xmn; u.nt = ntf / xs; u.kt0 = part * u.nt; u.split = (xs > 1); return true; }
        int wgid = (int)L; { const int q = nwg / NXCD, r = nwg % NXCD, xcd = wgid % NXCD, off = wgid / NXCD; wgid = (xcd < r ? xcd * (q + 1) : r * (q + 1) + (xcd - r) * q) + off; }
        const int nig = WGM * nN, gid = wgid / nig, fm = gid * WGM, gsz = (nM - fm) < WGM ? (nM - fm) : WGM;
        u.pm = fm + ((wgid % nig) % gsz); u.pn = (wgid % nig) / gsz; u.kt0 = 0; u.nt = ntf; u.split = 0; return true;
    }
};

struct EpiSwiglu {
    bf16_t* O;
    __device__ __forceinline__ void operator()(const f32x4 (&acc)[2][2][4][2], const Unit& u, int wr, int wc, int fr, int fq) const {
        const int row0 = u.pm * BM + wr * 64 + fr, col0 = u.pn * 128 + wc * 32 + 8 * fq;
#pragma unroll
        for (int ai = 0; ai < 2; ++ai)
#pragma unroll
            for (int m = 0; m < 4; ++m) {
                bf16_t* p = O + (size_t)(row0 + ai * HALF + m * 16) * DFF + col0;
                const f32x4 a0 = acc[ai][0][m][0], a1 = acc[ai][0][m][1], b0 = acc[ai][1][m][0], b1 = acc[ai][1][m][1];
                u32x4 w;
                w.x = cvt_pk(silu_f(a0[0]) * b0[0], silu_f(a0[1]) * b0[1]); w.y = cvt_pk(silu_f(a0[2]) * b0[2], silu_f(a0[3]) * b0[3]);
                w.z = cvt_pk(silu_f(a1[0]) * b1[0], silu_f(a1[1]) * b1[1]); w.w = cvt_pk(silu_f(a1[2]) * b1[2], silu_f(a1[3]) * b1[3]);
                *(u32x4*)p = w;
            }
    }
};
struct EpiResid {
    const float* res_lat; const float* res_ctx; float* out_lat; float* out_ctx; float* xp; const float* mx; int gate_off; float coef;
    __device__ __forceinline__ void operator()(const f32x4 (&acc)[2][2][4][2], const Unit& u, int wr, int wc, int fr, int fq) const {
        const bool lat = u.pm < 128; const int b = lat ? (u.pm >> 3) : 16;
        const float* res = lat ? res_lat + (size_t)u.pm * BM * D : res_ctx + (size_t)(u.pm - 128) * BM * D;
        float* out = lat ? out_lat + (size_t)u.pm * BM * D : out_ctx + (size_t)(u.pm - 128) * BM * D;
        const int col0 = u.pn * BM + wc * 32 + 4 * fq;
        const float* gp = mx + b * 9216 + gate_off + col0;
        const bool side = (u.kt0 != 0);
        f32x4 g[2][2];
#pragma unroll
        for (int bj = 0; bj < 2; ++bj)
#pragma unroll
            for (int n = 0; n < 2; ++n) g[bj][n] = *(const f32x4*)(gp + bj * HALF + n * 16);
        asm volatile("" ::: "memory");
#pragma unroll
        for (int bj = 0; bj < 2; ++bj)
#pragma unroll
            for (int n = 0; n < 2; ++n) g[bj][n] = g[bj][n] * coef;
        const unsigned rowoff = (unsigned)((wr * 64 + fr) * D + col0);
        if (side) {
            float* xq = xp + (size_t)(u.pm - 128) * BM * D;
#pragma unroll
            for (int grp = 0; grp < 8; ++grp) {
                const int ai = grp >> 2, m = grp & 3; const unsigned off = rowoff + (unsigned)((ai * HALF + m * 16) * D);
#pragma unroll
                for (int bj = 0; bj < 2; ++bj)
#pragma unroll
                    for (int n = 0; n < 2; ++n) *(f32x4*)(xq + off + bj * HALF + n * 16) = g[bj][n] * acc[ai][bj][m][n];
            }
            return;
        }
        f32x4 r0[2][2], r1[2][2], r2[2][2];
#pragma unroll
        for (int bj = 0; bj < 2; ++bj)
#pragma unroll
            for (int n = 0; n < 2; ++n) { r0[bj][n] = *(const f32x4*)(res + rowoff + bj * HALF + n * 16); r1[bj][n] = *(const f32x4*)(res + rowoff + 16 * D + bj * HALF + n * 16); }
#pragma unroll
        for (int grp = 0; grp < 8; ++grp) {
            const int ai = grp >> 2, m = grp & 3;
            const unsigned off = rowoff + (unsigned)((ai * HALF + m * 16) * D);
            if (grp < 6) {
                const unsigned offn = rowoff + (unsigned)((((grp + 2) >> 2) * HALF + ((grp + 2) & 3) * 16) * D);
#pragma unroll
                for (int bj = 0; bj < 2; ++bj)
#pragma unroll
                    for (int n = 0; n < 2; ++n) r2[bj][n] = *(const f32x4*)(res + offn + bj * HALF + n * 16);
            }
#pragma unroll
            for (int bj = 0; bj < 2; ++bj)
#pragma unroll
                for (int n = 0; n < 2; ++n) *(f32x4*)(out + off + bj * HALF + n * 16) = r0[bj][n] + g[bj][n] * acc[ai][bj][m][n];
#pragma unroll
            for (int bj = 0; bj < 2; ++bj)
#pragma unroll
                for (int n = 0; n < 2; ++n) { r0[bj][n] = r1[bj][n]; r1[bj][n] = r2[bj][n]; }
        }
    }
};
struct EpiWin {
    bf16_t* PB; const float* rc; const float* rs;
    __device__ __forceinline__ void operator()(const f32x4 (&acc)[2][2][4][2], const Unit& u, int wr, int wc, int fr, int fq) const {
        const int pn = u.pn, rowb = u.pm * BM + wr * 64 + fr;
        if (pn >= 1 && pn <= 4) {
            const bool lat = u.pm < 128; const float ksc = (pn >= 3) ? 0.08838834764831845f : 1.f;
            const int s = wc >> 1, f0 = 16 * (wc & 1) + 4 * fq;
            f32x4 csn = (f32x4){1.f, 1.f, 1.f, 1.f}, snn = (f32x4){0.f, 0.f, 0.f, 0.f};
            if (lat) { const int t = rowb & 2047, pos = s ? (t & 63) : (t >> 6); csn = *(const f32x4*)(rc + pos * 32 + f0); snn = *(const f32x4*)(rs + pos * 32 + f0); }
#pragma unroll
            for (int grp = 0; grp < 8; ++grp) {
                const int ai = grp >> 2, m = grp & 3;
                const int r = rowb + ai * HALF + m * 16;
                const f32x4 cs = csn * ksc, sn = snn * ksc;
                if (lat && grp < 7) { const int rn = rowb + ((grp + 1) >> 2) * HALF + ((grp + 1) & 3) * 16, t = rn & 2047, pos = s ? (t & 63) : (t >> 6);
                    csn = *(const f32x4*)(rc + pos * 32 + f0); snn = *(const f32x4*)(rs + pos * 32 + f0); }
#pragma unroll
                for (int bj = 0; bj < 2; ++bj) {
                    const f32x4 u1 = acc[ai][bj][m][0], u2 = acc[ai][bj][m][1];
                    const f32x4 o1 = u1 * cs - u2 * sn, o2 = u1 * sn + u2 * cs;
                    bf16_t* p = PB + (size_t)r * PBW + 256 * pn + 128 * bj + 64 * s + f0;
                    u32x2 w1, w2; w1.x = cvt_pk(o1[0], o1[1]); w1.y = cvt_pk(o1[2], o1[3]); w2.x = cvt_pk(o2[0], o2[1]); w2.y = cvt_pk(o2[2], o2[3]);
                    *(u32x2*)p = w1; *(u32x2*)(p + 32) = w2;
                }
            }
        } else if (pn >= 9) {
            const int col0 = 2304 + 128 * (pn - 9) + wc * 32 + 8 * fq;
#pragma unroll
            for (int ai = 0; ai < 2; ++ai)
#pragma unroll
                for (int m = 0; m < 4; ++m) {
                    const int r = rowb + ai * HALF + m * 16;
                    const f32x4 a0 = acc[ai][0][m][0], a1 = acc[ai][0][m][1], g0 = acc[ai][1][m][0], g1 = acc[ai][1][m][1];
                    u32x4 w;
                    w.x = cvt_pk(a0[0] * sigmoid_f(g0[0]), a0[1] * sigmoid_f(g0[1])); w.y = cvt_pk(a0[2] * sigmoid_f(g0[2]), a0[3] * sigmoid_f(g0[3]));
                    w.z = cvt_pk(a1[0] * sigmoid_f(g1[0]), a1[1] * sigmoid_f(g1[1])); w.w = cvt_pk(a1[2] * sigmoid_f(g1[2]), a1[3] * sigmoid_f(g1[3]));
                    *(u32x4*)(PB + (size_t)r * PBW + col0) = w;
                }
        } else {
            const int col0 = 256 * pn + wc * 32 + 8 * fq;
#pragma unroll
            for (int ai = 0; ai < 2; ++ai)
#pragma unroll
                for (int m = 0; m < 4; ++m) {
                    const int r = rowb + ai * HALF + m * 16;
#pragma unroll
                    for (int bj = 0; bj < 2; ++bj) {
                        const f32x4 v0 = acc[ai][bj][m][0], v1 = acc[ai][bj][m][1];
                        u32x4 w; w.x = cvt_pk(v0[0], v0[1]); w.y = cvt_pk(v0[2], v0[3]); w.z = cvt_pk(v1[0], v1[1]); w.w = cvt_pk(v1[2], v1[3]);
                        *(u32x4*)(PB + (size_t)r * PBW + col0 + 128 * bj) = w;
                    }
                }
        }
    }
};

template <class Epi, bool ALIGN_EPI>
__device__ __forceinline__ void gemm_phase(LAS unsigned char* lds, const Gemm g, const Order& S, const Epi& E) {
    int tid_ = threadIdx.x; asm volatile("" : "+v"(tid_));
    const int tid = tid_, wid = __builtin_amdgcn_readfirstlane(tid >> 6), lane = tid & 63, wr = wid >> 2, wc = wid & 3, fr = lane & 15, fq = lane >> 4;
    const int K = g.K;
    unsigned voff[2];
#pragma unroll
    for (int i = 0; i < 2; ++i) { int R, C; stage_rc(tid * 16 + i * 8192, R, C); voff[i] = (unsigned)(R * K + C) * 2u; }
    const size_t kstep = (size_t)(BK * 2);
    const size_t hstep = (size_t)HALF * K * 2;
    const size_t tstep = 2 * hstep;
    const unsigned ldsw = (unsigned)wid * 1024u;
    const int aoff = lds_byte(wr * 64 + fr, fq * 8), boff = lds_byte(wc * 32 + fr, fq * 8);
#define PG8_SA(b, h) (((b) * 2 + (h)) * HTB)
#define PG8_SB(b, h) ((4 + (b) * 2 + (h)) * HTB)
#define PG8_STAGE(bufoff, gbase) do { _Pragma("unroll") for (int _i = 0; _i < 2; ++_i) \
        __builtin_amdgcn_global_load_lds((const unsigned*)((const char*)(gbase) + voff[_i]), (LAS unsigned*)(lds + (bufoff) + ldsw + _i * 8192), 16, 0, 0); } while (0)
#define PG8_LDA(dst, b, h) do { _Pragma("unroll") for (int m = 0; m < 4; ++m) _Pragma("unroll") for (int k = 0; k < 2; ++k) dst[m][k] = *(const LAS bf16x8*)(lds + PG8_SA(b, h) + aoff + m * 2048 + k * 1024); } while (0)
#define PG8_LDB(dst, b, h) do { _Pragma("unroll") for (int n = 0; n < 2; ++n) _Pragma("unroll") for (int k = 0; k < 2; ++k) dst[n][k] = *(const LAS bf16x8*)(lds + PG8_SB(b, h) + boff + n * 2048 + k * 1024); } while (0)
#define PG8_MMA(ai, bj, At, Bt) do { __builtin_amdgcn_s_setprio(1); _Pragma("unroll") for (int m = 0; m < 4; ++m) _Pragma("unroll") for (int n = 0; n < 2; ++n) _Pragma("unroll") for (int k = 0; k < 2; ++k) \
        acc[ai][bj][m][n] = __builtin_amdgcn_mfma_f32_16x16x32_bf16(Bt[n][k], At[m][k], acc[ai][bj][m][n], 0, 0, 0); __builtin_amdgcn_s_setprio(0); } while (0)
#define PG8_WAIT_V(n) asm volatile("s_waitcnt vmcnt(" #n ")" ::: "memory")
#define PG8_WAIT_L(n) asm volatile("s_waitcnt lgkmcnt(" #n ")" ::: "memory")
#define PG8_BAR __builtin_amdgcn_s_barrier()
#define PG8_SCHED __builtin_amdgcn_sched_barrier(0)
    Unit cur, nxt; int ui = 0;
    if (!S.next(0, cur)) return;
    f32x4 acc[2][2][4][2];
#pragma unroll
    for (int a = 0; a < 2; ++a)
#pragma unroll
        for (int b = 0; b < 2; ++b)
#pragma unroll
            for (int m = 0; m < 4; ++m)
#pragma unroll
                for (int n = 0; n < 2; ++n) acc[a][b][m][n] = (f32x4){0.f, 0.f, 0.f, 0.f};
    bf16x8 At[4][2], B0[2][2], B1[2][2];
    const char* cA = (const char*)g.A + (size_t)cur.pm * tstep + (size_t)cur.kt0 * kstep; const char* cB = (const char*)g.Bt + (size_t)cur.pn * tstep + (size_t)cur.kt0 * kstep;
    PG8_STAGE(PG8_SB(0, 0), cB); PG8_STAGE(PG8_SB(0, 1), cB + hstep); PG8_STAGE(PG8_SA(0, 0), cA); PG8_STAGE(PG8_SA(0, 1), cA + hstep);
    if (wr == 1) PG8_BAR;
    PG8_WAIT_V(2); PG8_BAR;
    PG8_STAGE(PG8_SB(1, 0), cB + kstep); PG8_STAGE(PG8_SA(1, 0), cA + kstep); PG8_STAGE(PG8_SB(1, 1), cB + hstep + kstep);
    PG8_WAIT_V(6); PG8_BAR;
    for (;;) {
        const bool has_next = S.next(ui + 1, nxt);
        const char* nA = has_next ? (const char*)g.A + (size_t)nxt.pm * tstep + (size_t)nxt.kt0 * kstep : cA; const char* nB = has_next ? (const char*)g.Bt + (size_t)nxt.pn * tstep + (size_t)nxt.kt0 * kstep : cB;
        const int nt = cur.nt;
        for (int t = 0; t < nt; t += 2) {
            const bool last = (t == nt - 2);
            const char* a1 = cA + (size_t)(t + 1) * kstep;
            const char* a2 = last ? nA : cA + (size_t)(t + 2) * kstep; const char* b2 = last ? nB : cB + (size_t)(t + 2) * kstep;
            const char* a3 = a2 + kstep; const char* b3 = b2 + kstep;
            PG8_LDB(B0, 0, 0); PG8_LDB(B1, 0, 1); PG8_SCHED; PG8_LDA(At, 0, 0); PG8_STAGE(PG8_SA(1, 1), a1 + hstep);
            PG8_WAIT_V(8); PG8_WAIT_L(0); PG8_BAR; PG8_MMA(0, 0, At, B0); PG8_MMA(0, 1, At, B1); PG8_BAR; PG8_SCHED;
            PG8_LDA(At, 0, 1); PG8_STAGE(PG8_SB(0, 0), b2); PG8_STAGE(PG8_SB(0, 1), b2 + hstep); PG8_STAGE(PG8_SA(0, 0), a2);
            PG8_WAIT_V(8); PG8_WAIT_L(0); PG8_BAR; PG8_MMA(1, 0, At, B0); PG8_MMA(1, 1, At, B1); PG8_BAR; PG8_SCHED;
            PG8_LDB(B0, 1, 0); PG8_LDB(B1, 1, 1); PG8_SCHED; PG8_LDA(At, 1, 0); PG8_STAGE(PG8_SA(0, 1), a2 + hstep);
            PG8_WAIT_V(8); PG8_WAIT_L(0); PG8_BAR; PG8_MMA(0, 0, At, B0); PG8_MMA(0, 1, At, B1); PG8_BAR; PG8_SCHED;
            PG8_LDA(At, 1, 1); PG8_STAGE(PG8_SB(1, 0), b3); PG8_STAGE(PG8_SB(1, 1), b3 + hstep); PG8_STAGE(PG8_SA(1, 0), a3);
            PG8_WAIT_V(8); PG8_WAIT_L(0); PG8_BAR; PG8_MMA(1, 0, At, B0); PG8_MMA(1, 1, At, B1); PG8_BAR; PG8_SCHED;
        }
        if constexpr (ALIGN_EPI) { if (wr == 0) PG8_BAR; }
        E(acc, cur, wr, wc, fr, fq);
        if (!has_next) break;
#pragma unroll
        for (int a = 0; a < 2; ++a)
#pragma unroll
            for (int b = 0; b < 2; ++b)
#pragma unroll
                for (int m = 0; m < 4; ++m)
#pragma unroll
                    for (int n = 0; n < 2; ++n) acc[a][b][m][n] = (f32x4){0.f, 0.f, 0.f, 0.f};
        cur = nxt; cA = nA; cB = nB; ++ui;
        if constexpr (ALIGN_EPI) { if (wr == 1) PG8_BAR; }
    }
    PG8_WAIT_V(0);
    if constexpr (!ALIGN_EPI) { if (wr == 0) PG8_BAR; }
    PG8_BAR;
#undef PG8_SA
#undef PG8_SB
#undef PG8_STAGE
#undef PG8_LDA
#undef PG8_LDB
#undef PG8_MMA
#undef PG8_WAIT_V
#undef PG8_WAIT_L
#undef PG8_BAR
#undef PG8_SCHED
}

__device__ __forceinline__ const float* wsrc(const KA& a, int l, int mat, int rho, int& ldw) {
    const int j = rho & 3, fq = (rho >> 2) & 3, n = (rho >> 4) & 1, wc = (rho >> 5) & 3, bj = (rho >> 7) & 1, pn = rho >> 8;
    const int p8 = 8 * fq + 4 * n + j;
    if (mat == 0 || mat == 4) { const int s = (mat == 4); ldw = DFF; return (bj ? a.in(8) : a.in(7)) + (size_t)(l * 2 + s) * D * DFF + (128 * pn + 32 * wc + p8); }
    if (mat == 1 || mat == 5) { const int s = (mat == 5); ldw = D; return a.in(9) + (size_t)(l * 2 + s) * DFF * D + rho; }
    if (mat == 3) { ldw = D; return a.in(11) + (size_t)l * D * D + rho; }
    ldw = INW; int c;
    if (pn >= 1 && pn <= 4) { const int hh = 2 * ((pn - 1) & 1) + bj; c = (pn < 3 ? 256 : 768) + hh * 128 + 64 * (wc >> 1) + 32 * n + 16 * (wc & 1) + 4 * fq + j; }
    else if (pn >= 9) c = 2304 + 256 * bj + 128 * (pn - 9) + 32 * wc + p8;
    else c = (rho & ~31) + p8;
    return a.in(10) + (size_t)l * D * INW + c;
}

__device__ __forceinline__ void prep_phase(const KA& a, LAS unsigned char* lds, int tid, int bid, int G) {
    constexpr int N_MOD = 288;
    float* MX = (float*)(a.ws() + WS_MX);
    for (int it = bid; it < N_MOD + 2; it += G) {
        if (it < N_MOD) {
            const int l = it / 144, n0 = (it % 144) * 64;
            LAS float* Sv = (LAS float*)lds;
            LAS float* RED = (LAS float*)(lds + 69632);
            for (int idx = tid; idx < 17 * 1024; idx += 512) { const int r = idx >> 10, k = idx & 1023; const float v = r < 16 ? a.in(1)[r * 1024 + k] : a.in(3)[k]; Sv[idx] = v / (1.f + __expf(-v)); }
            __syncthreads();
            const int ks = tid >> 6, col = tid & 63;
            float acc[17];
#pragma unroll
            for (int r = 0; r < 17; ++r) acc[r] = 0.f;
            const float* wp = a.in(4) + ((size_t)l * 1024 + ks * 128) * 9216 + n0 + col;
            float w[16];
#pragma unroll
            for (int u = 0; u < 16; ++u) w[u] = wp[(size_t)u * 9216];
            for (int k16 = 0; k16 < 128; k16 += 16) {
                float wn[16];
                const int kn = (k16 + 16 < 128) ? k16 + 16 : k16;
#pragma unroll
                for (int u = 0; u < 16; ++u) wn[u] = wp[(size_t)(kn + u) * 9216];
#pragma unroll
                for (int u = 0; u < 16; ++u)
#pragma unroll
                    for (int r = 0; r < 17; ++r) acc[r] += Sv[r * 1024 + ks * 128 + k16 + u] * w[u];
#pragma unroll
                for (int u = 0; u < 16; ++u) w[u] = wn[u];
            }
#pragma unroll
            for (int r = 0; r < 17; ++r) RED[(ks * 17 + r) * 64 + col] = acc[r];
            __syncthreads();
            for (int idx = tid; idx < 17 * 64; idx += 512) {
                const int r = idx >> 6, c2 = idx & 63; float s = a.in(5)[l * 9216 + n0 + c2];
#pragma unroll
                for (int k8 = 0; k8 < 8; ++k8) s += RED[(k8 * 17 + r) * 64 + c2];
                MX[(size_t)(l * 17 + r) * 9216 + n0 + c2] = s;
            }
            __syncthreads();
        } else if (it == N_MOD) {
            float* rc = (float*)(a.ws() + WS_ROPE); float* rs = rc + 2048;
            for (int idx = tid; idx < 2048; idx += 512) { const int pos = idx >> 5, f = idx & 31; const float inv = __builtin_amdgcn_exp2f(-(float)f * 0.41524101186092029f);
                const float ang = (float)pos * inv; rc[idx] = __cosf(ang); rs[idx] = __sinf(ang); }
            if (tid < 16) { const int dir = tid >> 3, lh = tid & 7; const float x = (dir ? a.in(15) : a.in(14))[lh]; ((float*)(a.ws() + WS_DEC))[tid] = -__log2f(1.f + __expf(-x)); }
        } else {
            bf16_t* pwt = (bf16_t*)(a.ws() + WS_PWT);
            for (int idx = tid; idx < 2 * 4 * 64 * 64; idx += 512) { const int c = idx & 63, d = (idx >> 6) & 63, lg = idx >> 12; pwt[idx] = (bf16_t)(cvt_pk(a.in(12)[(lg * 64 + c) * 64 + d], 0.f) & 0xffffu); }
        }
    }
    {
        const int lane = tid & 63, wv = __builtin_amdgcn_readfirstlane(tid >> 6);
        LAS bf16_t* T = (LAS bf16_t*)(lds + 110592 + wv * 4224);
        const int cg4 = lane & 7, kr = lane >> 3;
#define TR_DECODE(t_, src_, ldw_, dstrow_, K_, k0_) do { const int l_ = (t_) / 10368; int r_ = (t_) % 10368; int mat_; size_t moff_; \
            if (r_ < 2816) { mat_ = 0; moff_ = WT_G1A; } else if (r_ < 4224) { mat_ = 1; r_ -= 2816; moff_ = WT_G2A; } else if (r_ < 5632) { mat_ = 2; r_ -= 4224; moff_ = WT_WIN; } \
            else if (r_ < 6144) { mat_ = 3; r_ -= 5632; moff_ = WT_WOUT; } else if (r_ < 8960) { mat_ = 4; r_ -= 6144; moff_ = WT_G1B; } else { mat_ = 5; r_ -= 8960; moff_ = WT_G2B; } \
            K_ = (mat_ == 1 || mat_ == 5) ? DFF : D; const int nrt_ = (mat_ == 0 || mat_ == 4) ? 176 : (mat_ == 2 ? 88 : 32), kt_ = r_ / nrt_, rt_ = r_ % nrt_; k0_ = kt_ * 64; \
            src_ = wsrc(a, l_, mat_, rt_ * 32 + 4 * cg4, ldw_); dstrow_ = (bf16_t*)(a.ws() + WS_WT) + (size_t)l_ * WT_LAYER + moff_ + (size_t)(rt_ * 32) * K_; } while (0)
        int t = bid * 8 + wv;
        if (t < 20736) {
            const float* src; int ldw, K, k0; bf16_t* dstrow;
            TR_DECODE(t, src, ldw, dstrow, K, k0);
            f32x4 v[8];
#pragma unroll
            for (int i = 0; i < 8; ++i) v[i] = *(const f32x4*)(src + (size_t)(k0 + kr + 8 * i) * ldw);
            for (;;) {
                const int tn = t + G * 8; const bool hasN = tn < 20736;
                const float* srcn = src; int ldwn = ldw, Kn = K, k0n = k0; bf16_t* dstrown = dstrow;
                f32x4 vn[8];
                if (hasN) { TR_DECODE(tn, srcn, ldwn, dstrown, Kn, k0n);
#pragma unroll
                    for (int i = 0; i < 8; ++i) vn[i] = *(const f32x4*)(srcn + (size_t)(k0n + kr + 8 * i) * ldwn); }
#pragma unroll
                for (int i = 0; i < 8; ++i)
#pragma unroll
                    for (int j = 0; j < 4; ++j) T[(4 * cg4 + j) * 66 + kr + 8 * i] = (bf16_t)(cvt_pk(v[i][j], 0.f) & 0xffffu);
                asm volatile("s_waitcnt lgkmcnt(0)" ::: "memory");
                const int r2 = lane >> 1, hf = lane & 1;
                const LAS unsigned* tp = (const LAS unsigned*)((const LAS unsigned char*)T + r2 * 132 + hf * 64);
                bf16_t* dst = dstrow + (size_t)r2 * K + k0 + hf * 32;
#pragma unroll
                for (int q = 0; q < 4; ++q) { u32x4 o; o.x = tp[4 * q]; o.y = tp[4 * q + 1]; o.z = tp[4 * q + 2]; o.w = tp[4 * q + 3]; *(u32x4*)(dst + 8 * q) = o; }
                asm volatile("s_waitcnt lgkmcnt(0)" ::: "memory");
                if (!hasN) break;
#pragma unroll
                for (int i = 0; i < 8; ++i) v[i] = vn[i];
                t = tn; src = srcn; ldw = ldwn; K = Kn; k0 = k0n; dstrow = dstrown;
            }
        }
#undef TR_DECODE
    }
}

__device__ __forceinline__ void norm_load(const KA& a, int row, const float* xl, const float* xc, bool addp, int lane, f32x4 (&v)[4]) {
    const bool lat = row < ML;
    const f32x4* xr = (const f32x4*)(lat ? xl + (size_t)row * D : xc + (size_t)(row - ML) * D) + lane;
#pragma unroll
    for (int j = 0; j < 4; ++j) v[j] = xr[64 * j];
    if (!lat && addp) {
        const f32x4* pr = (const f32x4*)(a.ws() + WS_XP + (size_t)(row - ML) * D * 4) + lane; f32x4* xw = (f32x4*)(a.ws() + WS_XC + (size_t)(row - ML) * D * 4) + lane;
#pragma unroll
        for (int j = 0; j < 4; ++j) { v[j] += pr[64 * j]; xw[64 * j] = v[j]; }
    }
}
struct NormPar { f32x4 sh[4], sc[4]; };
__device__ __forceinline__ void norm_params(const KA& a, int l, int s, int b, int lane, NormPar& P) {
    const float* mp = (const float*)(a.ws() + WS_MX) + (size_t)(l * 17 + b) * 9216 + (3 * s) * D;
#pragma unroll
    for (int j = 0; j < 4; ++j) { const int col = 256 * j + 4 * lane; P.sh[j] = *(const f32x4*)(mp + col); P.sc[j] = *(const f32x4*)(mp + D + col); }
}
__device__ __forceinline__ void norm_finish(const KA& a, int row, int lane, const f32x4 (&v)[4], const f32x4 (&g)[4], const NormPar& P) {
    bf16_t* H = (bf16_t*)(a.ws() + WS_H);
    float ss = 0.f;
#pragma unroll
    for (int j = 0; j < 4; ++j) ss += (v[j].x * v[j].x + v[j].y * v[j].y) + (v[j].z * v[j].z + v[j].w * v[j].w);
    const float rstd = 1.f / sqrtf(wave_sum(ss) * (1.f / D) + EPS);
    u32x2* o8 = (u32x2*)(H + (size_t)row * D) + lane;
#pragma unroll
    for (int j = 0; j < 4; ++j) {
        const f32x4 h = (v[j] * rstd * g[j]) * (P.sc[j] + 1.f) + P.sh[j];
        u32x2 w; w.x = cvt_pk(h.x, h.y); w.y = cvt_pk(h.z, h.w); o8[64 * j] = w;
    }
}
__device__ __forceinline__ int norm_row(int gw, int k, bool fast, int rpw) { return fast ? (k < 16 ? ((gw >> 7) << 11) + (gw & 127) + (k << 7) : ML + gw + ((k - 16) << 11)) : gw * rpw + k; }
__device__ __forceinline__ void norm_phase(const KA& a, int l, int s, int nrows, const float* xl, const float* xc, bool addp, int lane, int wid, int bid, int G) {
    const int NW = G * 8, gw = bid * 8 + wid; const bool fast = (NW == 2048);
    const int rpw = (nrows + NW - 1) / NW;
    const int nk = fast ? (nrows > ML ? 18 : 16) : max(0, min(rpw, nrows - gw * rpw));
    if (nk <= 0) return;
    f32x4 g[4];
    { const float* gp = a.in(6) + (l * 3 + s) * D;
#pragma unroll
      for (int j = 0; j < 4; ++j) g[j] = *(const f32x4*)(gp + 256 * j + 4 * lane); }
    int k = 0, row = norm_row(gw, 0, fast, rpw), rowB = norm_row(gw, 1, fast, rpw);
    int bcur = row < ML ? (row >> 11) : 16;
    NormPar P; norm_params(a, l, s, bcur, lane, P);
    bool hasB = 1 < nk;
    f32x4 va[4], vb[4];
    norm_load(a, row, xl, xc, addp, lane, va);
    if (hasB) norm_load(a, rowB, xl, xc, addp, lane, vb);
    for (;;) {
        const bool hasN = k + 2 < nk, hasNB = k + 3 < nk;
        const int nrow = norm_row(gw, k + 2, fast, rpw), nrowB = norm_row(gw, k + 3, fast, rpw);
        f32x4 na[4], nb[4];
        if (hasN) norm_load(a, nrow, xl, xc, addp, lane, na);
        if (hasNB) norm_load(a, nrowB, xl, xc, addp, lane, nb);
        { const int b0 = row < ML ? (row >> 11) : 16; if (b0 != bcur) { bcur = b0; norm_params(a, l, s, bcur, lane, P); } }
        norm_finish(a, row, lane, va, g, P);
        if (hasB) { const int b1 = rowB < ML ? (rowB >> 11) : 16; if (b1 != bcur) { bcur = b1; norm_params(a, l, s, bcur, lane, P); }
            norm_finish(a, rowB, lane, vb, g, P); }
        if (!hasN) break;
#pragma unroll
        for (int j = 0; j < 4; ++j) { va[j] = na[j]; vb[j] = nb[j]; }
        k += 2; row = nrow; rowB = nrowB; hasB = hasNB;
    }
}
__device__ __forceinline__ void final_phase(const KA& a, int lane, int wid, int bid, int G) {
    const int stride = G * 8;
    int row = bid * 8 + wid; if (row >= ML) return;
    f32x4 g[4];
#pragma unroll
    for (int j = 0; j < 4; ++j) g[j] = *(const f32x4*)(a.in(21) + 256 * j + 4 * lane);
    bool hasB = row + stride < ML;
    f32x4 va[4], vb[4];
    { const f32x4* xa = (const f32x4*)(a.out() + (size_t)row * D) + lane; const f32x4* xb = (const f32x4*)(a.out() + (size_t)(hasB ? row + stride : row) * D) + lane;
#pragma unroll
      for (int j = 0; j < 4; ++j) { va[j] = xa[64 * j]; vb[j] = xb[64 * j]; } }
    for (;;) {
        const int nrow = row + 2 * stride; const bool hasN = nrow < ML, hasNB = nrow + stride < ML;
        f32x4 na[4], nb[4];
        { const f32x4* xa = (const f32x4*)(a.out() + (size_t)(hasN ? nrow : row) * D) + lane; const f32x4* xb = (const f32x4*)(a.out() + (size_t)(hasNB ? nrow + stride : row) * D) + lane;
#pragma unroll
          for (int j = 0; j < 4; ++j) { na[j] = xa[64 * j]; nb[j] = xb[64 * j]; } }
        float sa = 0.f, sb = 0.f;
#pragma unroll
        for (int j = 0; j < 4; ++j) { sa += (va[j].x * va[j].x + va[j].y * va[j].y) + (va[j].z * va[j].z + va[j].w * va[j].w); sb += (vb[j].x * vb[j].x + vb[j].y * vb[j].y) + (vb[j].z * vb[j].z + vb[j].w * vb[j].w); }
        const float ra = 1.f / sqrtf(wave_sum(sa) * (1.f / D) + EPS), rb = 1.f / sqrtf(wave_sum(sb) * (1.f / D) + EPS);
        f32x4* oa = (f32x4*)(a.out() + (size_t)row * D) + lane; f32x4* ob = (f32x4*)(a.out() + (size_t)(row + stride) * D) + lane;
#pragma unroll
        for (int j = 0; j < 4; ++j) { oa[64 * j] = va[j] * ra * g[j]; if (hasB) ob[64 * j] = vb[j] * rb * g[j]; }
        if (!hasN) break;
#pragma unroll
        for (int j = 0; j < 4; ++j) { va[j] = na[j]; vb[j] = nb[j]; }
        row = nrow; hasB = hasNB;
    }
}

__device__ __forceinline__ void lds_barrier() { asm volatile("s_waitcnt lgkmcnt(0)" ::: "memory"); __builtin_amdgcn_s_barrier(); asm volatile("" ::: "memory"); }
constexpr int TS = 272;
struct TrRegs { u32x4 x[2][2]; };
struct RmRegs { u32x4 x[4]; };
__device__ __forceinline__ void load_tr(TrRegs& r, const bf16_t* src, int ld, int tid) {
#pragma unroll
    for (int i = 0; i < 2; ++i) { const int p = tid + 512 * i, jp = p & 63, o = p >> 6;
        const unsigned off = (unsigned)((2 * jp) * ld + o * 8);
        r.x[i][0] = *(const u32x4*)(src + off); r.x[i][1] = *(const u32x4*)(src + off + (unsigned)ld); }
}
__device__ __forceinline__ void store_tr(LAS unsigned char* dst, const TrRegs& r, int tid, bool weighted, float A, float Bc) {
#pragma unroll
    for (int i = 0; i < 2; ++i) {
        const int p = tid + 512 * i, jp = p & 63, o = p >> 6;
        const u32x4 x0 = r.x[i][0], x1 = r.x[i][1];
        const float w0 = weighted ? __builtin_amdgcn_exp2f(A + Bc * (float)(2 * jp)) : 1.f, w1 = weighted ? __builtin_amdgcn_exp2f(A + Bc * (float)(2 * jp + 1)) : 1.f;
#pragma unroll
        for (int c = 0; c < 8; ++c) {
            const unsigned a0 = x0[c >> 1], a1 = x1[c >> 1];
            const float e0 = (c & 1) ? bf_hi(a0) : bf_lo(a0), e1 = (c & 1) ? bf_hi(a1) : bf_lo(a1);
            *(LAS unsigned*)(dst + (8 * o + c) * TS + 4 * jp) = cvt_pk(e0 * w0, e1 * w1);
        }
    }
}
__device__ __forceinline__ void load_rm(RmRegs& r, const bf16_t* src, int ld, int tid) {
#pragma unroll
    for (int i = 0; i < 4; ++i) { const int p = tid + 512 * i, row = p >> 4, seg = p & 15; r.x[i] = *(const u32x4*)(src + (unsigned)(row * ld + seg * 8)); }
}
__device__ __forceinline__ void store_rm(LAS unsigned char* dst, const RmRegs& r, int tid) {
#pragma unroll
    for (int i = 0; i < 4; ++i) { const int p = tid + 512 * i, row = p >> 4, seg = p & 15; *(LAS u32x4*)(dst + row * TS + seg * 16) = r.x[i]; }
}
__device__ __forceinline__ bf16x8 frag(const LAS unsigned char* buf, int row, int ks, int fq) { return *(const LAS bf16x8*)(buf + row * TS + (32 * ks + 8 * fq) * 2); }

__device__ __forceinline__ void chunk_rows(int b, int vf, int& rows0, int& vb) {
    if (vf < 2) { rows0 = ML + b * CTXL + vf * 128; vb = 16 + vf; } else { rows0 = b * SEQ + (vf - 2) * 128; vb = vf - 2; }
}

__device__ __forceinline__ void kv_prefetch(const KA& a, TrRegs& rk, TrRegs& rv, int it, int tid) {
    const int b = it / 72, h = (it / 18) & 3, vf = it % 18; int rows0, vb; chunk_rows(b, vf, rows0, vb);
    const bf16_t* PB = (const bf16_t*)(a.ws() + WS_HID);
    load_tr(rk, PB + (size_t)rows0 * PBW + 768 + h * 128, PBW, tid); load_tr(rv, PB + (size_t)rows0 * PBW + 1280 + h * 128, PBW, tid);
}
__device__ __forceinline__ void kv_loop(const KA& a, int l, LAS unsigned char* lds, int tid, int lane, int wid, int bid, int G) {
    int it = bid; if (it >= 1152) return;
    TrRegs rk, rv; kv_prefetch(a, rk, rv, it, tid);
    LAS unsigned char* B0 = lds; LAS unsigned char* B1 = lds + 34816; LAS unsigned char* B2 = lds + 69632;
    const int fr = lane & 15, fq = lane >> 4;
    for (; it < 1152; it += G) {
        const int b = it / 72, h = (it / 18) & 3, vf = it % 18; int rows0, vb; chunk_rows(b, vf, rows0, vb);
        const float lf = log2gamma(a, 0, l, h), lb = log2gamma(a, 1, l, h);
        store_tr(B0, rk, tid, false, 0.f, 0.f); store_tr(B1, rv, tid, true, 127.f * lf, -lf); store_tr(B2, rv, tid, true, 0.f, lb);
        lds_barrier();
        kv_prefetch(a, rk, rv, (it + G < 1152) ? it + G : it, tid);
        bf16x8 af[4];
#pragma unroll
        for (int ks = 0; ks < 4; ++ks) af[ks] = frag(B0, 16 * wid + fr, ks, fq);
        bf16_t* KVF = (bf16_t*)(a.ws() + WS_KV) + ((size_t)(b * 4 + h) * 18 + vf) * 16384;
        bf16_t* KVB = (bf16_t*)(a.ws() + WS_KV) + (size_t)1152 * 16384 + ((size_t)(b * 4 + h) * 18 + vb) * 16384;
#pragma unroll
        for (int nb0 = 0; nb0 < 8; nb0 += 2) {
            bf16x8 f1[2][4], f2[2][4];
#pragma unroll
            for (int j = 0; j < 2; ++j)
#pragma unroll
                for (int ks = 0; ks < 4; ++ks) { f1[j][ks] = frag(B1, 16 * (nb0 + j) + fr, ks, fq); f2[j][ks] = frag(B2, 16 * (nb0 + j) + fr, ks, fq); }
            f32x4 cf[2], cb[2];
#pragma unroll
            for (int j = 0; j < 2; ++j) { cf[j] = (f32x4){0.f, 0.f, 0.f, 0.f}; cb[j] = (f32x4){0.f, 0.f, 0.f, 0.f}; }
            __builtin_amdgcn_s_setprio(1);
#pragma unroll
            for (int ks = 0; ks < 4; ++ks)
#pragma unroll
                for (int j = 0; j < 2; ++j) {
                    cf[j] = __builtin_amdgcn_mfma_f32_16x16x32_bf16(af[ks], f1[j][ks], cf[j], 0, 0, 0);
                    cb[j] = __builtin_amdgcn_mfma_f32_16x16x32_bf16(af[ks], f2[j][ks], cb[j], 0, 0, 0);
                }
            __builtin_amdgcn_s_setprio(0);
#pragma unroll
            for (int j = 0; j < 2; ++j) {
                const int off = (16 * (nb0 + j) + fr) * 128 + 16 * wid + 4 * fq;
                u32x2 w; w.x = cvt_pk(cf[j][0], cf[j][1]); w.y = cvt_pk(cf[j][2], cf[j][3]); *(u32x2*)(KVF + off) = w;
                w.x = cvt_pk(cb[j][0], cb[j][1]); w.y = cvt_pk(cb[j][2], cb[j][3]); *(u32x2*)(KVB + off) = w;
            }
        }
        lds_barrier();
    }
}

__device__ __forceinline__ void seq_tile(int idx, int& rowbase, int& L, int& t0) {
    if (idx < 512) { rowbase = (idx >> 5) * SEQ; L = SEQ; t0 = (idx & 31) * 64; } else { const int e = idx - 512; rowbase = ML + (e >> 2) * CTXL; L = CTXL; t0 = (e & 3) * 64; }
}

__device__ __forceinline__ void pool_tile_load(const KA& a, int idx, int tid, u32x4 (&pv)[5]) {
    int rowbase, L, t0; seq_tile(idx, rowbase, L, t0);
    const bf16_t* PB = (const bf16_t*)(a.ws() + WS_HID);
    unsigned zz = 0u; asm volatile("" : "+v"(zz));
#pragma unroll
    for (int k = 0; k < 5; ++k) { const int i = tid + 512 * k, rr = i >> 5, seg = i & 31, t = t0 - 8 + rr;
        pv[k] = (u32x4){zz, zz, zz, zz}; if (t >= 0 && t < L) pv[k] = *(const u32x4*)(PB + (size_t)(rowbase + t) * PBW + seg * 8); }
}
__device__ __forceinline__ void pool_loop(const KA& a, int l, int it0, int np, LAS unsigned char* lds, int tid, int lane, int wid, int G) {
    int idx = it0; if (idx >= np) return;
    bf16_t* CAT = (bf16_t*)(a.ws() + WS_H);
    LAS float* PT = (LAS float*)lds;
    LAS bf16_t* PL = (LAS bf16_t*)(lds + 81920);
    const int g = wid >> 1, thw = wid & 1, fr = lane & 15, fq = lane >> 4;
    bf16x8 wf[4][2]; f32x4 scv[4];
    { const bf16_t* pwt = (const bf16_t*)(a.ws() + WS_PWT) + (size_t)(l * 4 + g) * 4096; const float* psc = a.in(13) + l * 256 + g * 64;
#pragma unroll
      for (int mb = 0; mb < 4; ++mb) {
#pragma unroll
          for (int ks = 0; ks < 2; ++ks) wf[mb][ks] = *(const bf16x8*)(pwt + (16 * mb + fr) * 64 + 32 * ks + 8 * fq);
          scv[mb] = *(const f32x4*)(psc + 16 * mb + 4 * fq);
      } }
    u32x4 pv[5]; pool_tile_load(a, idx, tid, pv);
    for (;;) {
        int rowbase, L, t0; seq_tile(idx, rowbase, L, t0);
#pragma unroll
        for (int k = 0; k < 5; ++k) { const int i = tid + 512 * k, rr = i >> 5, seg = i & 31; const u32x4 v = pv[k];
            LAS f32x4* d = (LAS f32x4*)(PT + rr * 256 + seg * 8);
            d[0] = (f32x4){bf_lo(v.x), bf_hi(v.x), bf_lo(v.y), bf_hi(v.y)}; d[1] = (f32x4){bf_lo(v.z), bf_hi(v.z), bf_lo(v.w), bf_hi(v.w)}; }
        lds_barrier();
        const int nidx = idx + G; const bool hasN = nidx < np;
        if (hasN) pool_tile_load(a, nidx, tid, pv);
        {
            const int ch = tid & 255, th = tid >> 8, hw = 1 << (ch >> 6);
            const LAS float* col = PT + ch;
            const int tl0 = th * 32;
            float sw = 0.f;
            for (int uu = tl0 - hw; uu < tl0 + hw; ++uu) sw += col[(uu + 8) * 256];
#pragma unroll 8
            for (int tt = 0; tt < 32; ++tt) {
                const int tl = tl0 + tt, t = t0 + tl;
                const int lo = max(t - hw, 0), hi = min(t + hw, L);
                const float self = col[(tl + 8) * 256];
                const float val = sw * __builtin_amdgcn_rcpf((float)(hi - lo)) - self;
                PL[tl * 264 + ch] = (bf16_t)(cvt_pk(val, 0.f) & 0xffffu);
                sw += col[(tl + 8 + hw) * 256] - col[(tl + 8 - hw) * 256];
            }
        }
        lds_barrier();
#pragma unroll
        for (int tb = 0; tb < 2; ++tb) {
            const int tl = 32 * thw + 16 * tb + fr;
            bf16x8 bfr[2];
#pragma unroll
            for (int ks = 0; ks < 2; ++ks) bfr[ks] = *(const LAS bf16x8*)((const LAS unsigned char*)PL + tl * 528 + (g * 64 + 32 * ks + 8 * fq) * 2);
#pragma unroll
            for (int mb = 0; mb < 4; ++mb) {
                f32x4 c = (f32x4){0.f, 0.f, 0.f, 0.f};
#pragma unroll
                for (int ks = 0; ks < 2; ++ks) c = __builtin_amdgcn_mfma_f32_16x16x32_bf16(wf[mb][ks], bfr[ks], c, 0, 0, 0);
                c = c * scv[mb];
                u32x2 w; w.x = cvt_pk(c[0], c[1]); w.y = cvt_pk(c[2], c[3]);
                *(u32x2*)(CAT + (size_t)(rowbase + t0 + tl) * D + g * 64 + 16 * mb + 4 * fq) = w;
            }
        }
        lds_barrier();
        if (!hasN) break;
        idx = nidx;
    }
}

__device__ __forceinline__ void conv_tile_load(const KA& a, int idx, int tid, u32x4 (&cv)[6]) {
    int rowbase, L, t0; seq_tile(idx, rowbase, L, t0);
    const bf16_t* PB = (const bf16_t*)(a.ws() + WS_HID);
    unsigned zz = 0u; asm volatile("" : "+v"(zz));
#pragma unroll
    for (int k = 0; k < 6; ++k) { const int i = tid + 512 * k, rr = i >> 5, seg = i & 31, t = t0 - 15 + rr;
        cv[k] = (u32x4){zz, zz, zz, zz}; if (i < 94 * 32 && t >= 0 && t < L) cv[k] = *(const u32x4*)(PB + (size_t)(rowbase + t) * PBW + 2304 + seg * 8); }
}
__device__ __forceinline__ void conv_loop(const KA& a, int l, int it0, int np, LAS unsigned char* lds, int tid, int lane, int wid, int G) {
    int idx = it0; if (idx >= np) return;
    bf16_t* CAT = (bf16_t*)(a.ws() + WS_H);
    LAS bf16_t* ZT = (LAS bf16_t*)lds;
    LAS float* CO = (LAS float*)(lds + 48128);
    float wk[31]; float bias;
    { const int c = tid & 255; const float* dw = a.in(17) + (size_t)l * 31 * 256 + c;
#pragma unroll
      for (int k = 0; k < 31; ++k) wk[k] = dw[k * 256];
      bias = a.in(18)[l * 256 + c]; }
    const f32x4 lg = *(const f32x4*)(a.in(19) + l * 256 + 4 * lane), lbv = *(const f32x4*)(a.in(20) + l * 256 + 4 * lane);
    u32x4 cv[6]; conv_tile_load(a, idx, tid, cv);
    for (;;) {
        int rowbase, L, t0; seq_tile(idx, rowbase, L, t0);
#pragma unroll
        for (int k = 0; k < 6; ++k) { const int i = tid + 512 * k, rr = i >> 5, seg = i & 31; if (i < 94 * 32) *(LAS u32x4*)(lds + rr * 512 + seg * 16) = cv[k]; }
        lds_barrier();
        const int nidx = idx + G; const bool hasN = nidx < np;
        if (hasN) conv_tile_load(a, nidx, tid, cv);
        {
            const int c = tid & 255, th = tid >> 8;
            float zr[62];
#pragma unroll
            for (int uu = 0; uu < 62; ++uu) zr[uu] = __uint_as_float((unsigned)ZT[(32 * th + uu) * 256 + c] << 16);
            float acc[32];
#pragma unroll
            for (int t = 0; t < 32; ++t) acc[t] = bias;
#pragma unroll
            for (int k = 0; k < 31; ++k) {
#pragma unroll
                for (int t = 0; t < 32; ++t) acc[t] += zr[t + k] * wk[k];
            }
#pragma unroll
            for (int t = 0; t < 32; ++t) CO[(32 * th + t) * 260 + c] = acc[t];
        }
        lds_barrier();
#pragma unroll
        for (int tt = 0; tt < 8; ++tt) {
            const int tl = 8 * wid + tt;
            const f32x4 v = *(const LAS f32x4*)(CO + tl * 260 + 4 * lane);
            const float mu = wave_sum((v.x + v.y) + (v.z + v.w)) * (1.f / 256.f);
            const f32x4 dv = v - mu;
            const float var = wave_sum((dv.x * dv.x + dv.y * dv.y) + (dv.z * dv.z + dv.w * dv.w)) * (1.f / 256.f);
            const float rstd = 1.f / sqrtf(var + EPS);
            const f32x4 y = dv * rstd * lg + lbv;
            u32x2 w; w.x = cvt_pk(silu_f(y.x), silu_f(y.y)); w.y = cvt_pk(silu_f(y.z), silu_f(y.w));
            *(u32x2*)(CAT + (size_t)(rowbase + t0 + tl) * D + 768 + 4 * lane) = w;
        }
        lds_barrier();
        if (!hasN) break;
        idx = nidx;
    }
}

__device__ __forceinline__ bf16_t* scan_base(const KA& a, int u) {
    const int dir = u >> 17, bh = (u >> 11) & 63, e8 = u & 2047;
    return (bf16_t*)(a.ws() + WS_KV) + (size_t)dir * 1152 * 16384 + (size_t)bh * 18 * 16384 + e8 * 8;
}
__device__ __forceinline__ void scan_phase(const KA& a, int l, int tid, int bid, int G) {
    const int step = G * 512;
    int u = bid * 512 + tid; if (u >= 262144) return;
    u32x4 t[18];
    { const bf16_t* b0 = scan_base(a, u);
#pragma unroll
      for (int nn = 0; nn < 18; ++nn) t[nn] = *(const u32x4*)(b0 + (size_t)nn * 16384); }
    for (;;) {
        const int nu = u + step; const bool hasN = nu < 262144;
        u32x4 tn[18];
        if (hasN) { const bf16_t* bn = scan_base(a, nu);
#pragma unroll
            for (int nn = 0; nn < 18; ++nn) tn[nn] = *(const u32x4*)(bn + (size_t)nn * 16384); }
        const int dir = u >> 17, h = (u >> 11) & 3;
        bf16_t* base = scan_base(a, u);
        const float dec = __builtin_amdgcn_exp2f(128.f * log2gamma(a, dir, l, h));
        float S[8]; float zf = 0.f; asm volatile("" : "+v"(zf));
#pragma unroll
        for (int i = 0; i < 8; ++i) S[i] = zf;
        if (dir == 0) {
#pragma unroll
            for (int n = 0; n < 18; ++n) {
                const u32x4 v = t[n];
                u32x4 o; o.x = cvt_pk(S[0], S[1]); o.y = cvt_pk(S[2], S[3]); o.z = cvt_pk(S[4], S[5]); o.w = cvt_pk(S[6], S[7]);
                *(u32x4*)(base + (size_t)n * 16384) = o;
                S[0] = S[0] * dec + bf_lo(v.x); S[1] = S[1] * dec + bf_hi(v.x); S[2] = S[2] * dec + bf_lo(v.y); S[3] = S[3] * dec + bf_hi(v.y);
                S[4] = S[4] * dec + bf_lo(v.z); S[5] = S[5] * dec + bf_hi(v.z); S[6] = S[6] * dec + bf_lo(v.w); S[7] = S[7] * dec + bf_hi(v.w);
            }
        } else {
#pragma unroll
            for (int n = 17; n >= 0; --n) {
                const u32x4 v = t[n];
                u32x4 o; o.x = cvt_pk(S[0], S[1]); o.y = cvt_pk(S[2], S[3]); o.z = cvt_pk(S[4], S[5]); o.w = cvt_pk(S[6], S[7]);
                *(u32x4*)(base + (size_t)n * 16384) = o;
                S[0] = S[0] * dec + bf_lo(v.x); S[1] = S[1] * dec + bf_hi(v.x); S[2] = S[2] * dec + bf_lo(v.y); S[3] = S[3] * dec + bf_hi(v.y);
                S[4] = S[4] * dec + bf_lo(v.z); S[5] = S[5] * dec + bf_hi(v.z); S[6] = S[6] * dec + bf_lo(v.w); S[7] = S[7] * dec + bf_hi(v.w);
            }
        }
        if (!hasN) break;
#pragma unroll
        for (int nn = 0; nn < 18; ++nn) t[nn] = tn[nn];
        u = nu;
    }
}

struct RetPre { RmRegs rk; TrRegs rv; };
__device__ __forceinline__ void ret_decode(int it, int& b, int& h, int& vf) {
    if (it < 1024) { b = it >> 6; h = (it >> 4) & 3; vf = 2 + (it & 15); } else { const int e = it - 1024; b = e >> 3; h = (e >> 1) & 3; vf = e & 1; }
}
__device__ __forceinline__ void ret_prefetch(const KA& a, RetPre& R, int it, int tid, int iloc, int fq) {
    int b, h, vf; ret_decode(it, b, h, vf); int rows0, vb; chunk_rows(b, vf, rows0, vb);
    const bf16_t* PB = (const bf16_t*)(a.ws() + WS_HID);
    load_rm(R.rk, PB + (size_t)rows0 * PBW + 768 + h * 128, PBW, tid); load_tr(R.rv, PB + (size_t)rows0 * PBW + 1280 + h * 128, PBW, tid);
}
__device__ __forceinline__ void ret_prefetch_sf(const KA& a, RmRegs& rsf, bf16x8 (&qn)[4], int it, int tid, int iloc, int fq) {
    int b, h, vf; ret_decode(it, b, h, vf); int rows0, vb; chunk_rows(b, vf, rows0, vb);
    load_rm(rsf, (const bf16_t*)(a.ws() + WS_KV) + ((size_t)(b * 4 + h) * 18 + vf) * 16384, 128, tid);
    const bf16_t* Qs = (const bf16_t*)(a.ws() + WS_HID) + (size_t)rows0 * PBW + 256 + h * 128;
#pragma unroll
    for (int ks = 0; ks < 4; ++ks) qn[ks] = *(const bf16x8*)(Qs + (unsigned)(iloc * PBW + 32 * ks + 8 * fq));
}
__device__ __forceinline__ void retout_loop(const KA& a, int l, int nit, LAS unsigned char* lds, int tid, int lane, int wid, int bid, int G) {
    int it = bid; if (it >= nit) return;
    const int fr = lane & 15, fq = lane >> 4, iloc_ = 16 * wid + fr;
    RetPre R; ret_prefetch(a, R, it, tid, iloc_, fq);
    RmRegs rsf; bf16x8 qn[4]; ret_prefetch_sf(a, rsf, qn, it, tid, iloc_, fq);
    LAS unsigned char* B0 = lds; LAS unsigned char* B1 = lds + 34816; LAS unsigned char* B2 = lds + 69632; LAS unsigned char* PBUF = lds + 104448;
    for (; it < nit; it += G) {
        int b, h, vf; ret_decode(it, b, h, vf); int rows0, vb; chunk_rows(b, vf, rows0, vb);
        int iloc = iloc_; asm volatile("" : "+v"(iloc));
        const bf16_t* PB = (const bf16_t*)(a.ws() + WS_HID); bf16_t* CAT = (bf16_t*)(a.ws() + WS_H);
        const bf16_t* Gs = PB + (size_t)rows0 * PBW + 1792 + h * 128;
        const bf16_t* SB = (const bf16_t*)(a.ws() + WS_KV) + (size_t)1152 * 16384 + ((size_t)(b * 4 + h) * 18 + vb) * 16384;
        const float lf = log2gamma(a, 0, l, h), lb = log2gamma(a, 1, l, h);
        bf16x8 qa[4];
#pragma unroll
        for (int ks = 0; ks < 4; ++ks) qa[ks] = qn[ks];
        store_rm(B0, R.rk, tid); store_tr(B1, R.rv, tid, false, 0.f, 0.f); store_rm(B2, rsf, tid);
        lds_barrier();
        RmRegs rsb; load_rm(rsb, SB, 128, tid);
        ret_prefetch(a, R, (it + G < nit) ? it + G : it, tid, iloc, fq);
#pragma unroll
        for (int nb0 = 0; nb0 < 8; nb0 += 4) {
            bf16x8 kf[4][4];
#pragma unroll
            for (int j = 0; j < 4; ++j)
#pragma unroll
                for (int ks = 0; ks < 4; ++ks) kf[j][ks] = frag(B0, 16 * (nb0 + j) + fr, ks, fq);
            f32x4 c[4];
#pragma unroll
            for (int j = 0; j < 4; ++j) c[j] = (f32x4){0.f, 0.f, 0.f, 0.f};
#pragma unroll
            for (int ks = 0; ks < 4; ++ks)
#pragma unroll
                for (int j = 0; j < 4; ++j) c[j] = __builtin_amdgcn_mfma_f32_16x16x32_bf16(kf[j][ks], qa[ks], c[j], 0, 0, 0);
#pragma unroll
            for (int j = 0; j < 4; ++j) {
                const int nb = nb0 + j; float p[4];
#pragma unroll
                for (int r = 0; r < 4; ++r) { const int df = iloc - (16 * nb + 4 * fq + r); p[r] = c[j][r] * (df >= 0 ? __builtin_amdgcn_exp2f((float)df * lf) : __builtin_amdgcn_exp2f((float)(-df) * lb)); }
                u32x2 w; w.x = cvt_pk(p[0], p[1]); w.y = cvt_pk(p[2], p[3]);
                *(LAS u32x2*)(PBUF + iloc * TS + (16 * nb + 4 * fq) * 2) = w;
            }
        }
        f32x4 O[8];
        const float wf = __builtin_amdgcn_exp2f((float)(iloc + 1) * lf), wb = __builtin_amdgcn_exp2f((float)(128 - iloc) * lb);
#pragma unroll
        for (int nb0 = 0; nb0 < 8; nb0 += 4) {
            bf16x8 sf[4][4];
#pragma unroll
            for (int j = 0; j < 4; ++j)
#pragma unroll
                for (int ks = 0; ks < 4; ++ks) sf[j][ks] = frag(B2, 16 * (nb0 + j) + fr, ks, fq);
            f32x4 c[4];
#pragma unroll
            for (int j = 0; j < 4; ++j) c[j] = (f32x4){0.f, 0.f, 0.f, 0.f};
#pragma unroll
            for (int ks = 0; ks < 4; ++ks)
#pragma unroll
                for (int j = 0; j < 4; ++j) c[j] = __builtin_amdgcn_mfma_f32_16x16x32_bf16(sf[j][ks], qa[ks], c[j], 0, 0, 0);
#pragma unroll
            for (int j = 0; j < 4; ++j) O[nb0 + j] = c[j] * wf;
        }
        lds_barrier();
        store_rm(B0, rsb, tid);
        {
            bf16x8 pf[4];
#pragma unroll
            for (int ks = 0; ks < 4; ++ks) pf[ks] = frag(PBUF, iloc, ks, fq);
#pragma unroll
            for (int nb0 = 0; nb0 < 8; nb0 += 4) {
                bf16x8 vf4[4][4];
#pragma unroll
                for (int j = 0; j < 4; ++j)
#pragma unroll
                    for (int ks = 0; ks < 4; ++ks) vf4[j][ks] = frag(B1, 16 * (nb0 + j) + fr, ks, fq);
#pragma unroll
                for (int ks = 0; ks < 4; ++ks)
#pragma unroll
                    for (int j = 0; j < 4; ++j) O[nb0 + j] = __builtin_amdgcn_mfma_f32_16x16x32_bf16(vf4[j][ks], pf[ks], O[nb0 + j], 0, 0, 0);
            }
        }
        lds_barrier();
        u32x2 gv[8];
#pragma unroll
        for (int nb = 0; nb < 8; ++nb) gv[nb] = *(const u32x2*)(Gs + (unsigned)(iloc * PBW + 16 * nb + 4 * fq));
        f32x4 ggv[8];
        { const float* gnp = a.in(16) + l * 512 + h * 128 + 4 * fq;
#pragma unroll
          for (int nb = 0; nb < 8; ++nb) ggv[nb] = *(const f32x4*)(gnp + 16 * nb); }
        ret_prefetch_sf(a, rsf, qn, (it + G < nit) ? it + G : it, tid, iloc, fq);
#pragma unroll
        for (int nb0 = 0; nb0 < 8; nb0 += 4) {
            bf16x8 bfm[4][4];
#pragma unroll
            for (int j = 0; j < 4; ++j)
#pragma unroll
                for (int ks = 0; ks < 4; ++ks) bfm[j][ks] = frag(B0, 16 * (nb0 + j) + fr, ks, fq);
            f32x4 c[4];
#pragma unroll
            for (int j = 0; j < 4; ++j) c[j] = (f32x4){0.f, 0.f, 0.f, 0.f};
#pragma unroll
            for (int ks = 0; ks < 4; ++ks)
#pragma unroll
                for (int j = 0; j < 4; ++j) c[j] = __builtin_amdgcn_mfma_f32_16x16x32_bf16(bfm[j][ks], qa[ks], c[j], 0, 0, 0);
#pragma unroll
            for (int j = 0; j < 4; ++j) O[nb0 + j] += c[j] * wb;
        }
        float s = 0.f;
#pragma unroll
        for (int nb = 0; nb < 8; ++nb) s += (O[nb][0] + O[nb][1]) + (O[nb][2] + O[nb][3]);
        s += __shfl_xor(s, 16); s += __shfl_xor(s, 32);
        const float mu = s * (1.f / 128.f);
        float q = 0.f;
#pragma unroll
        for (int nb = 0; nb < 8; ++nb) { const f32x4 d = O[nb] - mu; q += (d[0] * d[0] + d[1] * d[1]) + (d[2] * d[2] + d[3] * d[3]); }
        q += __shfl_xor(q, 16); q += __shfl_xor(q, 32);
        const float rstd = 1.f / sqrtf(q * (1.f / 128.f) + EPS);
#pragma unroll
        for (int nb = 0; nb < 8; ++nb) {
            const int e0 = 16 * nb + 4 * fq;
            const f32x4 y = (O[nb] - mu) * rstd * ggv[nb];
            u32x2 w; w.x = cvt_pk(y[0] * silu_f(bf_lo(gv[nb].x)), y[1] * silu_f(bf_hi(gv[nb].x))); w.y = cvt_pk(y[2] * silu_f(bf_lo(gv[nb].y)), y[3] * silu_f(bf_hi(gv[nb].y)));
            *(u32x2*)(CAT + (size_t)(rows0 + iloc) * D + 256 + h * 128 + e0) = w;
        }
        lds_barrier();
    }
}

#define XB_TMO      128
#define XB_XCNT(j)  (256  + 64 * (j))
#define XB_XSUB(j)  (1280 + 64 * (j))
#define XB_XGEN(j)  (2304 + 64 * (j))
#define XB_TOP      3328
#define XB_TOPGEN   3392
#define XCD_BAR_WORDS 3456
#define XB_SPIN_CAP (1u << 18)

__device__ __forceinline__ unsigned xb_ld(unsigned* p)              { return __hip_atomic_load(p, __ATOMIC_RELAXED, __HIP_MEMORY_SCOPE_AGENT); }
__device__ __forceinline__ unsigned xb_add(unsigned* p, unsigned v) { return __hip_atomic_fetch_add(p, v, __ATOMIC_RELAXED, __HIP_MEMORY_SCOPE_AGENT); }
__device__ __forceinline__ unsigned xb_xcc_id() { return (unsigned)__builtin_amdgcn_s_getreg((3 << 11) | 20) & 0xFu; }
#define XB_SPIN(cond, bar) do { unsigned _sp = 0; while (cond) { __builtin_amdgcn_s_sleep(1); \
    if ((++_sp & 255u) == 0u) { if (xb_ld(&(bar)[XB_TMO])) break; if (_sp > XB_SPIN_CAP) { atomicAdd(&(bar)[XB_TMO], 1u); break; } } } } while (0)

struct XcdBarrier {
    unsigned* bar; unsigned x;
    volatile LAS unsigned* st;
};

__device__ __forceinline__ XcdBarrier xcd_barrier_post(unsigned* bar, volatile LAS unsigned* st) {
    XcdBarrier b; b.bar = bar; b.x = xb_xcc_id(); b.st = st;
    if (threadIdx.x == 0) (void)xb_add(&bar[XB_XCNT(b.x)], 1u);
    return b;
}
__device__ __forceinline__ void xcd_barrier_complete(unsigned* bar, unsigned x, unsigned& nloc, unsigned& nx) {
    const unsigned G = gridDim.x * gridDim.y * gridDim.z;
    unsigned sum, cnt, mine, sp = 0u;
    for (;;) {
        sum = 0u; cnt = 0u; mine = 0u;
#pragma unroll
        for (unsigned j = 0; j < 16; ++j) { const unsigned c = xb_ld(&bar[XB_XCNT(j)]); sum += c; cnt += (c > 0u) ? 1u : 0u; mine = (j == x) ? c : mine; }
        if (sum == G) break;
        __builtin_amdgcn_s_sleep(1);
        if ((++sp & 255u) == 0u) { if (xb_ld(&bar[XB_TMO])) break; if (sp > XB_SPIN_CAP) { atomicAdd(&bar[XB_TMO], 1u); break; } }
    }
    nloc = mine > 0u ? mine : 1u; nx = cnt > 0u ? cnt : 1u;
}

__device__ __forceinline__ void xcd_barrier(const XcdBarrier& b) {
    asm volatile("s_waitcnt vmcnt(0)" ::: "memory");
    __syncthreads();
    if (threadIdx.x == 0) {
        unsigned* bar = b.bar;
        __builtin_amdgcn_s_waitcnt(0);
        unsigned nloc = b.st[0], nx = b.st[1];
        if (nloc == 0u) { xcd_barrier_complete(bar, b.x, nloc, nx); b.st[0] = nloc; b.st[1] = nx; }
        const unsigned old = xb_add(&bar[XB_XSUB(b.x)], 1u);
        const unsigned gen = old / nloc;
        if (old + 1u == (gen + 1u) * nloc) {
            __builtin_amdgcn_fence(__ATOMIC_RELEASE, "agent");
            asm volatile("s_waitcnt vmcnt(0)" ::: "memory");
            const unsigned og = xb_add(&bar[XB_TOP], 1u);
            const unsigned tg = og / nx;
            if (og + 1u == (tg + 1u) * nx) xb_add(&bar[XB_TOPGEN], 1u);
            else XB_SPIN(xb_ld(&bar[XB_TOPGEN]) == tg, bar);
            __builtin_amdgcn_fence(__ATOMIC_ACQUIRE, "agent");
            xb_add(&bar[XB_XGEN(b.x)], 1u);
            asm volatile("s_waitcnt vmcnt(0)" ::: "memory");
        } else {
            XB_SPIN(xb_ld(&bar[XB_XGEN(b.x)]) == gen, bar);
            __builtin_amdgcn_fence(__ATOMIC_ACQUIRE, "agent");
            asm volatile("s_waitcnt vmcnt(0)" ::: "memory");
        }
    }
    __syncthreads();
}


__global__ void __launch_bounds__(512, 2) fwd_kernel(Args a_) {
    extern __shared__ __attribute__((aligned(16))) unsigned char lds_raw[];
    LAS unsigned char* lds = (LAS unsigned char*)lds_raw;
    const int G = gridDim.x, bid = blockIdx.x;
    volatile LAS unsigned* bst = (volatile LAS unsigned*)(lds + LDS_BYTES - 64);
    if (threadIdx.x < 2) bst[threadIdx.x] = 0u;
    __syncthreads();
    if (a_.ph_hi - a_.ph_lo > 1) (void)xcd_barrier_post((unsigned*)(a_.ws + WS_BAR), bst);

    for (int ph = a_.ph_lo; ph < a_.ph_hi; ++ph) {
        int tid_ = threadIdx.x; asm volatile("" : "+v"(tid_));
        const int tid = tid_, lane = tid & 63, wid = __builtin_amdgcn_readfirstlane(tid >> 6);
        int kz; asm volatile("s_mov_b32 %0, 0" : "=s"(kz));
        KA a; a.kb = (const char*)__builtin_amdgcn_kernarg_segment_ptr() + kz;
        float* XC = (float*)(a.ws() + WS_XC);
        bf16_t* Hb = (bf16_t*)(a.ws() + WS_H);
        bf16_t* HID = (bf16_t*)(a.ws() + WS_HID);
        const float* MXb = (const float*)(a.ws() + WS_MX);
        if (ph == 0) prep_phase(a, lds, tid, bid, G);
        else if (ph == NPH - 1) final_phase(a, lane, wid, bid, G);
        else {
            const int l = (ph - 1) / 12, s = (ph - 1) % 12;
            const bool first = (l == 0), lastl = (l == 1);
            const bf16_t* WT = (const bf16_t*)(a.ws() + WS_WT) + (size_t)l * WT_LAYER;
            if (s == 0 || s == 3 || s == 9) {
                const int sub = s == 0 ? 0 : (s == 3 ? 1 : 2);
                const bool in0 = first && s == 0;
                const int nrows = (lastl && s == 9) ? ML : MT;
                norm_phase(a, l, sub, nrows, in0 ? a.in(0) : a.out(), in0 ? a.in(2) : XC, !in0, lane, wid, bid, G);
            } else if (s == 1 || s == 10) {
                Gemm g{Hb, WT + (s == 1 ? WT_G1A : WT_G1B), D};
                Order S; S.init(((lastl && s == 10) ? ML : MT) / BM, (2 * DFF) / BM, D, G, bid);
                EpiSwiglu E{HID};
                gemm_phase<EpiSwiglu, true>(lds, g, S, E);
            } else if (s == 2 || s == 8 || s == 11) {
                const bool in0 = first && s == 2;
                Gemm g{s == 8 ? Hb : HID, WT + (s == 2 ? WT_G2A : (s == 8 ? WT_WOUT : WT_G2B)), s == 8 ? D : DFF};
                Order S; S.init(ML / BM, D / BM, s == 8 ? D : DFF, G, bid);
                if (!(lastl && s != 2)) { S.xn = 128; S.xm0 = 128; S.xmn = 16; S.xn0 = 0; S.xs = 2; }
                EpiResid E{in0 ? a.in(0) : a.out(), in0 ? a.in(2) : XC, a.out(), XC, (float*)(a.ws() + WS_XP), MXb + (size_t)l * 17 * 9216, (s == 2 ? 2 : (s == 8 ? 5 : 8)) * D, s == 8 ? 1.f : 0.5f};
                gemm_phase<EpiResid, true>(lds, g, S, E);
            } else if (s == 4) {
                Gemm g{Hb, WT + WT_WIN, D};
                Order S; S.init((lastl ? ML : MT) / BM, INW / BM, D, G, bid);
                if (lastl) { S.xn = 64; S.xm0 = 128; S.xmn = 16; S.xn0 = 3; }
                EpiWin E{HID, (const float*)(a.ws() + WS_ROPE), (const float*)(a.ws() + WS_ROPE) + 2048};
                gemm_phase<EpiWin, true>(lds, g, S, E);
            } else if (s == 5) {
                const int np = lastl ? 512 : 576;
                kv_loop(a, l, lds, tid, lane, wid, bid, G);
                {
                    const int it0 = (bid + G / 2) % G;
                    conv_loop(a, l, it0, np, lds, tid, lane, wid, G);
                    int it = it0; while (it < np) it += G;
                    pool_loop(a, l, it - np, np, lds, tid, lane, wid, G);
                }
            } else if (s == 6) {
                scan_phase(a, l, tid, bid, G);
            } else if (s == 7) {
                retout_loop(a, l, lastl ? 1024 : 1152, lds, tid, lane, wid, bid, G);
            }
        }
        if (ph + 1 < a_.ph_hi) { if (a_.ph_lo < 0) cg::this_grid().sync(); else { XcdBarrier xb; xb.bar = (unsigned*)(a.ws() + WS_BAR); xb.x = xb_xcc_id(); xb.st = bst; xcd_barrier(xb); } }
    }
}

extern "C" void kernel_launch(void* const* d_in, const int* in_sizes, int n_in, void* d_out, int out_size, void* d_ws, size_t ws_size, hipStream_t stream) {
    static int grid = 0;
    if (grid == 0) {
        if (n_in != 22 || out_size != ML * D || ws_size < WS_END) { fprintf(stderr, "kernel_launch: unexpected shapes (n_in %d out %d ws %zu need %zu)\n", n_in, out_size, ws_size, (size_t)WS_END); grid = -1; return; }
        int dev = 0, cus = 0, per_cu = 0;
        hipGetDevice(&dev);
        hipDeviceGetAttribute(&cus, hipDeviceAttributeMultiprocessorCount, dev);
        if (hipFuncSetAttribute((const void*)fwd_kernel, hipFuncAttributeMaxDynamicSharedMemorySize, LDS_BYTES) != hipSuccess) { fprintf(stderr, "kernel_launch: hipFuncSetAttribute failed\n"); grid = -1; return; }
        hipOccupancyMaxActiveBlocksPerMultiprocessor(&per_cu, (const void*)fwd_kernel, 512, LDS_BYTES);
        if (per_cu < 1) { fprintf(stderr, "kernel_launch: occupancy query says %d blocks per CU\n", per_cu); per_cu = 1; }
        (void)hipGetLastError();
        grid = cus * 1;
    }
    if (grid < 0) return;
    Args a{};
    for (int i = 0; i < 22; ++i) a.in[i] = (const float*)d_in[i];
    a.out = (float*)d_out; a.ws = (unsigned char*)d_ws;
#if ONE_LAUNCH
    a.ph_lo = 0; a.ph_hi = NPH;
    if (hipMemsetAsync((char*)d_ws + WS_BAR, 0, 16384, stream) != hipSuccess) { fprintf(stderr, "kernel_launch: memset of barrier words failed\n"); return; }
    void* args[] = {&a};
    hipError_t e = hipLaunchCooperativeKernel((const void*)fwd_kernel, dim3(grid), dim3(512), args, LDS_BYTES, stream);
    if (e != hipSuccess) fprintf(stderr, "cooperative launch failed: %s (grid %d)\n", hipGetErrorString(e), grid);
#else
    for (int ph = 0; ph < NPH; ++ph) {
        a.ph_lo = ph; a.ph_hi = ph + 1;
        hipLaunchKernelGGL(fwd_kernel, dim3(grid), dim3(512), LDS_BYTES, stream, a);
    }
#endif
}
```
